# Optimizing an MI355X kernel written in HIP

```python
import jax, jax.numpy as jnp
from jax import lax
import numpy as np

D_MODEL = 1024
BATCH = 4
SEQ = 8192
DEPTH = 2
DEC_BATCH = 32
DEC_SEQ = 4
PAST_LEN = 16384
PAGE_SIZE = 128

N_EVEN = (DEPTH + 1) // 2
N_ODD = DEPTH // 2
W_CONV = D_MODEL // 2
CONV_WIDTH = 31
N_HEADS = 8
HEAD_DIM = 64
KV_HEADS = 2
GROUP = N_HEADS // KV_HEADS
W_ATTN = N_HEADS * HEAD_DIM
KV_W = 2 * KV_HEADS * HEAD_DIM
CMP_STRIDE = 16
CMP_BLOCK = 2 * CMP_STRIDE
SEL_BLOCK = 64
N_SEL = 16
WINDOW = 512
Q_BLOCK = 128
W_POOL = D_MODEL
POOL_WINDOWS = (2, 4, 8, 16)
N_POOL_GROUPS = 4
POOL_GROUP_W = W_POOL // N_POOL_GROUPS
POOL_MAX = 16
LN_EPS = 1e-5
NEG_INF = -1e30
SEL_FORCE = 1e9
DEEPNORM_ALPHA = (2 * DEPTH) ** 0.25
DEEPNORM_BETA = (8 * DEPTH) ** -0.25
EVEN_SPLITS = (W_CONV, W_CONV, W_CONV, W_ATTN, KV_W, KV_W, KV_W, 3 * N_HEADS, W_ATTN)
E_IN = 3 * W_CONV + 2 * W_ATTN + 3 * KV_W + 3 * N_HEADS

kernel_name = 'hybrid_conv_nsa_pool_decoder_step'


def layer_norm(x, g, b):
    xf = x.astype(jnp.float32)
    mu = xf.mean(-1, keepdims=True)
    var = jnp.square(xf - mu).mean(-1, keepdims=True)
    y = (xf - mu) * lax.rsqrt(var + LN_EPS) * g.astype(jnp.float32) + b.astype(jnp.float32)
    return y.astype(x.dtype)


def masked_softmax(s, mask):
    s = jnp.where(mask, s.astype(jnp.float32), NEG_INF)
    return jax.nn.softmax(s, axis=-1) * mask


def even_project(x, w_in):
    B, T, _ = x.shape
    h = jnp.einsum('btd,de->bte', x, w_in)
    offsets = np.cumsum(EVEN_SPLITS)[:-1].tolist()
    a_val, a_glu, a_gate, q, kv_c, kv_s, kv_w, g, b_gate = jnp.split(h, offsets, axis=-1)
    kv_shape = (B, T, 2, KV_HEADS, HEAD_DIM)
    u = a_val * jax.nn.sigmoid(a_glu)
    return (u, a_gate, q.reshape(B, T, N_HEADS, HEAD_DIM), kv_c.reshape(kv_shape),
            kv_s.reshape(kv_shape), kv_w.reshape(kv_shape), g.reshape(B, T, N_HEADS, 3), b_gate)


def conv_branch(u_ext, a_gate, conv_w, conv_b, ln_g, ln_b):
    y = lax.conv_general_dilated(u_ext, conv_w[:, None, :], (1,), 'VALID',
                                 dimension_numbers=('NWC', 'WIO', 'NWC'),
                                 feature_group_count=W_CONV) + conv_b
    return jax.nn.silu(layer_norm(y, ln_g, ln_b)) * jax.nn.silu(a_gate)


def compress_kv(kv, w_cmp):
    B, L = kv.shape[:2]
    n_ch = L // CMP_STRIDE
    ch = kv[:, :n_ch * CMP_STRIDE].reshape(B, n_ch, CMP_STRIDE, 2, KV_HEADS, HEAD_DIM)
    kc = (jnp.einsum('bnjchd,jchd->bnchd', ch[:, :-1], w_cmp[:CMP_STRIDE])
          + jnp.einsum('bnjchd,jchd->bnchd', ch[:, 1:], w_cmp[CMP_STRIDE:]))
    kc_end = jnp.arange(n_ch - 1) * CMP_STRIDE + (CMP_BLOCK - 1)
    return kc[:, :, 0], kc[:, :, 1], kc_end


def select_blocks(kv):
    B, L = kv.shape[:2]
    ns = -(-L // SEL_BLOCK)
    kv = jnp.pad(kv, ((0, 0), (0, ns * SEL_BLOCK - L), (0, 0), (0, 0), (0, 0)))
    kv = kv.reshape(B, ns, SEL_BLOCK, 2, KV_HEADS, HEAD_DIM).transpose(3, 0, 4, 1, 2, 5)
    return kv[0], kv[1]


def nsa_block(q, g, q_pos, kc, vc, kc_end, ks, vs, kw, vw, kw_pos):
    B, Q = q.shape[:2]
    qg = q.reshape(B, Q, KV_HEADS, GROUP, HEAD_DIM) * (HEAD_DIM ** -0.5)
    s_c = jnp.einsum('bqhgd,bnhd->bhgqn', qg, kc)
    p_c = masked_softmax(s_c, kc_end[None, :] <= q_pos[:, None])
    o_c = jnp.einsum('bhgqn,bnhd->bqhgd', p_c.astype(vc.dtype), vc)
    ns, nc = ks.shape[2], kc.shape[1]
    per = SEL_BLOCK // CMP_STRIDE
    p_grp = jnp.pad(p_c.sum(2), ((0, 0), (0, 0), (0, 0), (0, per * ns - nc)))
    score = p_grp.reshape(B, KV_HEADS, Q, ns, per)[..., :per - 1].sum(-1)
    blk = jnp.arange(ns)[None, :]
    cur = (q_pos // SEL_BLOCK)[:, None]
    forced = (blk == 0) | ((blk >= cur - 1) & (blk <= cur))
    score = jnp.where(forced, SEL_FORCE, jnp.where(blk <= cur, score, -SEL_FORCE))
    n_top = min(N_SEL, ns)
    _, idx = lax.top_k(score, n_top)
    bi = jnp.arange(B)[:, None, None, None]
    hi = jnp.arange(KV_HEADS)[None, :, None, None]
    n_keys = n_top * SEL_BLOCK
    k_sel = ks[bi, hi, idx].reshape(B, KV_HEADS, Q, n_keys, HEAD_DIM)
    v_sel = vs[bi, hi, idx].reshape(B, KV_HEADS, Q, n_keys, HEAD_DIM)
    pos_sel = (idx[..., None] * SEL_BLOCK + jnp.arange(SEL_BLOCK)).reshape(B, KV_HEADS, Q, n_keys)
    s_s = jnp.einsum('bqhgd,bhqnd->bhgqn', qg, k_sel)
    p_s = masked_softmax(s_s, (pos_sel <= q_pos[:, None])[:, :, None])
    o_s = jnp.einsum('bhgqn,bhqnd->bqhgd', p_s.astype(v_sel.dtype), v_sel)
    rel = q_pos[:, None] - kw_pos[None, :]
    s_w = jnp.einsum('bqhgd,bwhd->bhgqw', qg, kw)
    p_w = masked_softmax(s_w, (rel >= 0) & (rel < WINDOW) & (kw_pos[None, :] >= 0))
    o_w = jnp.einsum('bhgqw,bwhd->bqhgd', p_w.astype(vw.dtype), vw)
    gq = jax.nn.sigmoid(g.reshape(B, Q, KV_HEADS, GROUP, 3).astype(jnp.float32)).astype(q.dtype)
    o = gq[..., 0:1] * o_c + gq[..., 1:2] * o_s + gq[..., 2:3] * o_w
    return o.reshape(B, Q, W_ATTN)


def mixer_out(a_out, b_out, b_gate, w_out):
    h = jnp.concatenate([a_out, b_out * jax.nn.silu(b_gate)], axis=-1)
    return jnp.einsum('bte,ed->btd', h, w_out)


def even_prompt(x, w_in, w_cmp, conv_w, conv_b, ln_g, ln_b, w_out):
    B, T, _ = x.shape
    u, a_gate, q, kv_c, kv_s, kv_w, g, b_gate = even_project(x, w_in)
    u_ext = jnp.pad(u, ((0, 0), (CONV_WIDTH - 1, 0), (0, 0)))
    a_out = conv_branch(u_ext, a_gate, conv_w, conv_b, ln_g, ln_b)
    kc, vc, kc_end = compress_kv(kv_c, w_cmp)
    ks, vs = select_blocks(kv_s)
    kw_pad = jnp.pad(kv_w, ((0, 0), (WINDOW, 0), (0, 0), (0, 0), (0, 0)))
    n_qb = T // Q_BLOCK
    q_b = jnp.swapaxes(q.reshape(B, n_qb, Q_BLOCK, N_HEADS, HEAD_DIM), 0, 1)
    g_b = jnp.swapaxes(g.reshape(B, n_qb, Q_BLOCK, N_HEADS, 3), 0, 1)

    def query_block(args):
        i, q_i, g_i = args
        start = i * Q_BLOCK
        kw_i = lax.dynamic_slice_in_dim(kw_pad, start, WINDOW + Q_BLOCK, axis=1)
        q_pos = start + jnp.arange(Q_BLOCK)
        kw_pos = start - WINDOW + jnp.arange(WINDOW + Q_BLOCK)
        return nsa_block(q_i, g_i, q_pos, kc, vc, kc_end, ks, vs, kw_i[:, :, 0], kw_i[:, :, 1], kw_pos)

    b_out = lax.map(query_block, (jnp.arange(n_qb), q_b, g_b))
    b_out = jnp.swapaxes(b_out, 0, 1).reshape(B, T, W_ATTN)
    y = mixer_out(a_out, b_out, b_gate, w_out)
    return y, kv_c, kv_s, kv_w[:, -min(WINDOW, T):], u_ext[:, -(CONV_WIDTH - 1):]


def even_sample(x, cache_c, cache_s, win_buf, conv_buf, page_table, w_in, w_cmp, conv_w, conv_b, ln_g, ln_b, w_out):
    B, T, _ = x.shape
    past_len = page_table.shape[1] * cache_c.shape[1]
    u, a_gate, q, kv_c, kv_s, kv_w, g, b_gate = even_project(x, w_in)
    u_ext = jnp.concatenate([conv_buf.astype(u.dtype), u], axis=1)
    a_out = conv_branch(u_ext, a_gate, conv_w, conv_b, ln_g, ln_b)

    def paged_rows(cache, new):
        past = cache[page_table].reshape((B, past_len) + cache.shape[2:])
        return jnp.concatenate([past.astype(new.dtype), new], axis=1)

    kc, vc, kc_end = compress_kv(paged_rows(cache_c, kv_c), w_cmp)
    ks, vs = select_blocks(paged_rows(cache_s, kv_s))
    win_ext = jnp.concatenate([win_buf.astype(kv_w.dtype), kv_w], axis=1)
    w_len = win_ext.shape[1]
    q_pos = past_len + jnp.arange(T)
    kw_pos = past_len + T - w_len + jnp.arange(w_len)
    b_out = nsa_block(q, g, q_pos, kc, vc, kc_end, ks, vs, win_ext[:, :, 0], win_ext[:, :, 1], kw_pos)
    y = mixer_out(a_out, b_out, b_gate, w_out)
    return y, kv_c, kv_s, win_ext[:, -min(WINDOW, w_len):], u_ext[:, -(CONV_WIDTH - 1):]


def pool_mixer(x, buf, pos0, w_in, w_grp, scale, w_out):
    B, T, _ = x.shape
    v, gate = jnp.split(jnp.einsum('btd,de->bte', x, w_in), 2, axis=-1)
    P = POOL_MAX - 1
    ext = jnp.concatenate([buf.astype(v.dtype), v], axis=1)
    cs = jnp.pad(jnp.cumsum(ext.astype(jnp.float32), axis=1), ((0, 0), (1, 0), (0, 0)))
    pos = pos0 + jnp.arange(T)
    means = []
    for gi, w in enumerate(POOL_WINDOWS):
        c0, c1 = gi * POOL_GROUP_W, (gi + 1) * POOL_GROUP_W
        win_sum = cs[:, P + 1:P + 1 + T, c0:c1] - cs[:, P + 1 - w:P + 1 - w + T, c0:c1]
        cnt = jnp.minimum(pos + 1, w).astype(jnp.float32)[None, :, None]
        means.append(win_sum / cnt)
    mean = jnp.stack(means, axis=2)
    d = (mean - v.reshape(B, T, N_POOL_GROUPS, POOL_GROUP_W).astype(jnp.float32)).astype(v.dtype)
    mixed = jnp.einsum('btgc,gce->btge', d, w_grp).reshape(B, T, W_POOL) * scale
    y = jnp.einsum('bte,ed->btd', mixed * jax.nn.silu(gate), w_out)
    return y, ext[:, -P:]


def setup_inputs(seed: int = 0) -> dict:
    key = jax.random.key(seed)
    ks = jax.random.split(key, 24)
    n_pages = PAST_LEN // PAGE_SIZE
    n_phys = (DEC_BATCH * n_pages * 5) // 4
    win_buf = min(WINDOW, PAST_LEN)
    nrm = jax.random.normal
    f32 = jnp.float32
    page_table = jax.random.permutation(ks[0], n_phys)[:DEC_BATCH * n_pages].reshape(DEC_BATCH, n_pages).astype(jnp.int32)
    cache_shape = (N_EVEN, n_phys, PAGE_SIZE, 2, KV_HEADS, HEAD_DIM)
    return {
        'x_prompt': nrm(ks[1], (BATCH, SEQ, D_MODEL), f32),
        'x_sample': nrm(ks[2], (DEC_BATCH, DEC_SEQ, D_MODEL), f32),
        'cache_kv_cmp': nrm(ks[3], cache_shape, f32),
        'cache_kv_sel': nrm(ks[4], cache_shape, f32),
        'state_win_kv': nrm(ks[5], (N_EVEN, DEC_BATCH, win_buf, 2, KV_HEADS, HEAD_DIM), f32),
        'state_conv': 0.5 * nrm(ks[6], (N_EVEN, DEC_BATCH, CONV_WIDTH - 1, W_CONV), f32),
        'state_pool': nrm(ks[7], (N_ODD, DEC_BATCH, POOL_MAX - 1, W_POOL), f32),
        'page_table': page_table,
        'w_in_even': nrm(ks[8], (N_EVEN, D_MODEL, E_IN), f32) * D_MODEL ** -0.5,
        'w_cmp': (1.0 + 0.1 * nrm(ks[9], (N_EVEN, CMP_BLOCK, 2, KV_HEADS, HEAD_DIM), f32)) / CMP_BLOCK,
        'conv_w': nrm(ks[10], (N_EVEN, CONV_WIDTH, W_CONV), f32) * CONV_WIDTH ** -0.5,
        'conv_b': 0.02 * nrm(ks[11], (N_EVEN, W_CONV), f32),
        'conv_ln_g': 1.0 + 0.05 * nrm(ks[12], (N_EVEN, W_CONV), f32),
        'conv_ln_b': 0.02 * nrm(ks[13], (N_EVEN, W_CONV), f32),
        'w_out_even': nrm(ks[14], (N_EVEN, W_CONV + W_ATTN, D_MODEL), f32) * (W_CONV + W_ATTN) ** -0.5 * DEEPNORM_BETA,
        'w_in_odd': nrm(ks[15], (N_ODD, D_MODEL, 2 * W_POOL), f32) * D_MODEL ** -0.5,
        'w_pool_grp': nrm(ks[16], (N_ODD, N_POOL_GROUPS, POOL_GROUP_W, POOL_GROUP_W), f32) * POOL_GROUP_W ** -0.5,
        'pool_scale': 1.0 + 0.05 * nrm(ks[17], (N_ODD, W_POOL), f32),
        'w_out_odd': nrm(ks[18], (N_ODD, W_POOL, D_MODEL), f32) * W_POOL ** -0.5 * DEEPNORM_BETA,
        'ln_g': 1.0 + 0.05 * nrm(ks[19], (DEPTH, D_MODEL), f32),
        'ln_b': 0.02 * nrm(ks[20], (DEPTH, D_MODEL), f32),
    }


def reference(x_prompt, x_sample, cache_kv_cmp, cache_kv_sel, state_win_kv, state_conv, state_pool, page_table,
              w_in_even, w_cmp, conv_w, conv_b, conv_ln_g, conv_ln_b, w_out_even,
              w_in_odd, w_pool_grp, pool_scale, w_out_odd, ln_g, ln_b):
    xp, xs = x_prompt, x_sample
    past_len = page_table.shape[1] * cache_kv_cmp.shape[2]
    kvc_p, kvs_p, win_p, conv_p, pool_p = [], [], [], [], []
    kvc_s, kvs_s, win_s, conv_s, pool_s = [], [], [], [], []
    for layer in range(DEPTH):
        j = layer // 2
        if layer % 2 == 0:
            dp, a1, a2, a3, a4 = even_prompt(xp, w_in_even[j], w_cmp[j], conv_w[j], conv_b[j],
                                             conv_ln_g[j], conv_ln_b[j], w_out_even[j])
            ds, b1, b2, b3, b4 = even_sample(xs, cache_kv_cmp[j], cache_kv_sel[j], state_win_kv[j], state_conv[j],
                                             page_table, w_in_even[j], w_cmp[j], conv_w[j], conv_b[j],
                                             conv_ln_g[j], conv_ln_b[j], w_out_even[j])
            kvc_p.append(a1); kvs_p.append(a2); win_p.append(a3); conv_p.append(a4)
            kvc_s.append(b1); kvs_s.append(b2); win_s.append(b3); conv_s.append(b4)
        else:
            buf0 = jnp.zeros((xp.shape[0], POOL_MAX - 1, W_POOL), xp.dtype)
            dp, a5 = pool_mixer(xp, buf0, 0, w_in_odd[j], w_pool_grp[j], pool_scale[j], w_out_odd[j])
            ds, b5 = pool_mixer(xs, state_pool[j], past_len, w_in_odd[j], w_pool_grp[j], pool_scale[j], w_out_odd[j])
            pool_p.append(a5); pool_s.append(b5)
        xp = layer_norm(DEEPNORM_ALPHA * xp + dp, ln_g[layer], ln_b[layer])
        xs = layer_norm(DEEPNORM_ALPHA * xs + ds, ln_g[layer], ln_b[layer])
    return (xp, xs,
            jnp.stack(kvc_p), jnp.stack(kvs_p), jnp.stack(win_p), jnp.stack(conv_p), jnp.stack(pool_p),
            jnp.stack(kvc_s), jnp.stack(kvs_s), jnp.stack(win_s), jnp.stack(conv_s), jnp.stack(pool_s))
```

```cpp
#include <hip/hip_runtime.h>
#include <cstdio>
#include <cstdint>

#ifndef N_LAUNCH_MODE
#define N_LAUNCH_MODE 1
#endif

#define LAS __attribute__((address_space(3)))
#define GAS __attribute__((address_space(1)))
typedef unsigned short bf16_t;
typedef short bf16x8 __attribute__((ext_vector_type(8)));
typedef short s16x4 __attribute__((ext_vector_type(4)));
typedef float f32x4 __attribute__((ext_vector_type(4)));
typedef float f32x2 __attribute__((ext_vector_type(2)));
typedef float f32x16 __attribute__((ext_vector_type(16)));
typedef unsigned u32x4 __attribute__((ext_vector_type(4)));
typedef unsigned u32x2 __attribute__((ext_vector_type(2)));

constexpr int DM = 1024, NBATCH = 4, SEQ = 8192, MP = NBATCH * SEQ, DB = 32, DS = 4, MS = DB * DS, MR = MP + MS, MA = 33024;
constexpr int PAST = 16384, PAGE = 128, NPAGES = PAST / PAGE;
constexpr int WC = 512, WA = 512, KVW = 256, E_IN = 3352, N1 = 3584;
constexpr float LN_EPS = 1e-5f, ALPHA = 1.41421356237309515f;
constexpr float C2 = 0.125f * 1.4426950408889634f;
constexpr float NEGB = -1e30f;
constexpr size_t O_Y = 0, O_YS = 33554432, O_KC = O_YS + 131072, O_KSEL = O_KC + 8388608, O_WIN = O_KSEL + 8388608, O_CONV = O_WIN + 524288,
                 O_POOL = O_CONV + 61440, O_KCS = O_POOL + 61440, O_KSS = O_KCS + 32768, O_WINS = O_KSS + 32768, O_CONVS = O_WINS + 4194304,
                 O_POOLS = O_CONVS + 491520, O_TOTAL = O_POOLS + 491520;
constexpr size_t MiB = 1u << 20;
constexpr size_t WS_CTL = 0, CTL_ZERO_BYTES = 1 * MiB;
constexpr size_t WS_W1T = 2 * MiB, WS_W2T = 9 * MiB, WS_W3T = 11 * MiB, WS_W4T = 15 * MiB, WS_W5T = 16 * MiB, WS_KC = 18 * MiB, WS_SELM = 19 * MiB, WS_SELMS = 20 * MiB,
                 WS_G = 21 * MiB, WS_KCS = 25 * MiB, WS_XA = 48 * MiB, WS_U = 113 * MiB, WS_AG = 146 * MiB, WS_Q = 179 * MiB, WS_BG = 212 * MiB, WS_KS = 245 * MiB,
                 WS_KW = 262 * MiB, WS_OC = 279 * MiB, WS_H2 = 312 * MiB, WS_DP = 377 * MiB, WS_X1 = 507 * MiB, WS_X1A = 636 * MiB, WS_V = 701 * MiB, WS_GT = 766 * MiB,
                 WS_DM = 831 * MiB, WS_MX = 896 * MiB, WS_DP2 = 961 * MiB, WS_END = 1091 * MiB;
constexpr int CW_BAR = 4096;

constexpr int NWAVES = 8, NTHR = 512;
constexpr int LDS_BYTES = 147456, RING_BYTES = 131072, MISC_OFF = RING_BYTES + 320;

struct Prm {
    const float *x_prompt, *x_sample, *cache_c, *cache_s, *state_win, *state_conv, *state_pool;
    const int* page_table;
    const float *w_in_even, *w_cmp, *conv_w, *conv_b, *conv_ln_g, *conv_ln_b, *w_out_even, *w_in_odd, *w_grp, *pool_scale, *w_out_odd, *ln_g, *ln_b;
    float* out; unsigned char* ws;
    int ph_lo, ph_hi;
};

__device__ __forceinline__ unsigned f2bf(float f) { unsigned u = __builtin_bit_cast(unsigned, f); return (u + 0x7fffu + ((u >> 16) & 1u)) >> 16; }
__device__ __forceinline__ unsigned pk2(float lo, float hi) { return f2bf(lo) | (f2bf(hi) << 16); }
__device__ __forceinline__ float bf2f(unsigned short h) { return __builtin_bit_cast(float, (unsigned)h << 16); }
__device__ __forceinline__ float bflo(unsigned w) { return __builtin_bit_cast(float, w << 16); }
__device__ __forceinline__ float bfhi(unsigned w) { return __builtin_bit_cast(float, w & 0xffff0000u); }
__device__ __forceinline__ float sigmoidf_(float x) { return __builtin_amdgcn_rcpf(1.0f + __expf(-x)); }
__device__ __forceinline__ float siluf_(float x) { return x * sigmoidf_(x); }
__device__ __forceinline__ float ex2(float x) { return __builtin_amdgcn_exp2f(x); }
__device__ __forceinline__ float wave_sum(float v) {
#pragma unroll
    for (int o = 1; o < 64; o <<= 1) v += __shfl_xor(v, o);
    return v;
}
__device__ __forceinline__ float wave_max(float v) {
#pragma unroll
    for (int o = 1; o < 64; o <<= 1) v = fmaxf(v, __shfl_xor(v, o));
    return v;
}
__device__ __forceinline__ int crow(int r, int hi) { return (r & 3) + 8 * (r >> 2) + 4 * hi; }
#define LDS_WAIT() asm volatile("s_waitcnt lgkmcnt(0)" ::: "memory")

namespace pg8 {
constexpr int BM = 256, BK = 64, HALF = 128, HTB = HALF * BK * 2, STAGE_BYTES = 8 * HTB, NXCD = 8, WGM = 8;
__host__ __device__ __forceinline__ int lds_byte(int r, int c) { const int st = (r >> 4) * 2 + (c >> 5), rr = r & 15, cc = c & 31, ob = rr * 64 + cc * 2; return st * 1024 + (ob ^ (((ob >> 9) & 1) << 5)); }
__host__ __device__ __forceinline__ void stage_rc(int b, int& R, int& C) { const int st = b / 1024, sb = b % 1024, swz = sb ^ (((sb >> 9) & 1) << 5); R = (st >> 1) * 16 + swz / 64; C = (st & 1) * 32 + (swz % 64) / 2; }
__host__ __device__ __forceinline__ int perm32(int rho) { const int n = rho >> 4, i = rho & 15; return 8 * (i >> 2) + 4 * n + (i & 3); }
struct Unit { int pm, pn; };
struct Gemm { const bf16_t* A; const bf16_t* Bt; int lda, ldb, K, a_pn_off; };
struct StaticOrder {
    int nM, nN, nwg, G, c;
    __host__ __device__ void init(int M, int N, int G_, int c_) { nM = M / BM; nN = N / BM; nwg = nM * nN; G = G_; c = c_; }
    __host__ __device__ bool next(int i, Unit& u) const {
        const long L = (long)i * G + c; if (L >= nwg) return false;
        int wgid = (int)L; { const int q = nwg / NXCD, r = nwg % NXCD, xcd = wgid % NXCD, off = wgid / NXCD; wgid = (xcd < r ? xcd * (q + 1) : r * (q + 1) + (xcd - r) * q) + off; }
        const int nig = WGM * nN, gid = wgid / nig, fm = gid * WGM, gsz = (nM - fm) < WGM ? (nM - fm) : WGM;
        u.pm = fm + ((wgid % nig) % gsz); u.pn = (wgid % nig) / gsz; return true;
    }
};
template <class Epi, class Sched, bool ALIGN_EPI = true>
__device__ __forceinline__ void gemm_phase(LAS unsigned char* lds, const Gemm g, const Sched& S, const Epi& E) {
    const int tid = threadIdx.x, wid = __builtin_amdgcn_readfirstlane(tid >> 6), lane = tid & 63, wr = wid >> 2, wc = wid & 3, fr = lane & 15, fq = lane >> 4;
    const int K = g.K, nt = K / BK;
    unsigned voffA[2], voffB[2];
#pragma unroll
    for (int i = 0; i < 2; ++i) { int R, C; stage_rc(tid * 16 + i * 8192, R, C); const int Rb = Epi::PERM ? ((R & ~31) + perm32(R & 31)) : R;
        voffA[i] = (unsigned)(R * g.lda + C) * 2u; voffB[i] = (unsigned)(Rb * g.ldb + C) * 2u; }
    const size_t kstep = (size_t)(BK * 2);
    const size_t hstepA = (size_t)HALF * g.lda * 2, hstepB = (size_t)HALF * g.ldb * 2;
    const size_t tstepA = 2 * hstepA, tstepB = 2 * hstepB;
    const unsigned ldsw = (unsigned)wid * 1024u;
    const int aoff = lds_byte(wr * 64 + fr, fq * 8), boff = lds_byte(wc * 32 + fr, fq * 8);
#define PG8_SA(b, h) (((b) * 2 + (h)) * HTB)
#define PG8_SB(b, h) ((4 + (b) * 2 + (h)) * HTB)
#define PG8_STAGE(bufoff, gbase, voff) do { _Pragma("unroll") for (int _i = 0; _i < 2; ++_i) \
        __builtin_amdgcn_global_load_lds((const unsigned*)((const char*)(gbase) + (voff)[_i]), (LAS unsigned*)(lds + (bufoff) + ldsw + _i * 8192), 16, 0, 0); } while (0)
#define PG8_LDA(dst, b, h) do { _Pragma("unroll") for (int m = 0; m < 4; ++m) _Pragma("unroll") for (int k = 0; k < 2; ++k) dst[m][k] = *(const LAS bf16x8*)(lds + PG8_SA(b, h) + aoff + m * 2048 + k * 1024); } while (0)
#define PG8_LDB(dst, b, h) do { _Pragma("unroll") for (int n = 0; n < 2; ++n) _Pragma("unroll") for (int k = 0; k < 2; ++k) dst[n][k] = *(const LAS bf16x8*)(lds + PG8_SB(b, h) + boff + n * 2048 + k * 1024); } while (0)
#define PG8_MMA(ai, bj, At, Bt) do { __builtin_amdgcn_s_setprio(1); _Pragma("unroll") for (int m = 0; m < 4; ++m) _Pragma("unroll") for (int n = 0; n < 2; ++n) _Pragma("unroll") for (int k = 0; k < 2; ++k) \
        acc[ai][bj][m][n] = __builtin_amdgcn_mfma_f32_16x16x32_bf16(Bt[n][k], At[m][k], acc[ai][bj][m][n], 0, 0, 0); __builtin_amdgcn_s_setprio(0); } while (0)
#define PG8_WAIT_V(n) asm volatile("s_waitcnt vmcnt(" #n ")" ::: "memory")
#define PG8_WAIT_L(n) asm volatile("s_waitcnt lgkmcnt(" #n ")" ::: "memory")
#define PG8_BAR __builtin_amdgcn_s_barrier()
#define PG8_SCHED __builtin_amdgcn_sched_barrier(0)
    Unit cur, nxt; int ui = 0;
    if (!S.next(0, cur)) return;
    f32x4 acc[2][2][4][2];
#pragma unroll
    for (int a = 0; a < 2; ++a)
#pragma unroll
        for (int b = 0; b < 2; ++b)
#pragma unroll
            for (int m = 0; m < 4; ++m)
#pragma unroll
                for (int n = 0; n < 2; ++n) acc[a][b][m][n] = (f32x4){0.f, 0.f, 0.f, 0.f};
    bf16x8 At[4][2], B0[2][2], B1[2][2];
    const char* cA = (const char*)g.A + (size_t)cur.pm * tstepA + (size_t)cur.pn * g.a_pn_off * 2; const char* cB = (const char*)g.Bt + (size_t)cur.pn * tstepB;
    {
        PG8_STAGE(PG8_SB(0, 0), cB, voffB); PG8_STAGE(PG8_SB(0, 1), cB + hstepB, voffB); PG8_STAGE(PG8_SA(0, 0), cA, voffA); PG8_STAGE(PG8_SA(0, 1), cA + hstepA, voffA);
        if (wr == 1) PG8_BAR;
        PG8_WAIT_V(2); PG8_BAR;
        PG8_STAGE(PG8_SB(1, 0), cB + kstep, voffB); PG8_STAGE(PG8_SA(1, 0), cA + kstep, voffA); PG8_STAGE(PG8_SB(1, 1), cB + hstepB + kstep, voffB);
        PG8_WAIT_V(6); PG8_BAR;
    }
    for (;;) {
        const bool has_next = S.next(ui + 1, nxt);
        const char* nA = has_next ? (const char*)g.A + (size_t)nxt.pm * tstepA + (size_t)nxt.pn * g.a_pn_off * 2 : cA; const char* nB = has_next ? (const char*)g.Bt + (size_t)nxt.pn * tstepB : cB;
        for (int t = 0; t < nt; t += 2) {
            const bool last = (t == nt - 2);
            const char* a1 = cA + (size_t)(t + 1) * kstep;
            const char* a2 = last ? nA : cA + (size_t)(t + 2) * kstep; const char* b2 = last ? nB : cB + (size_t)(t + 2) * kstep;
            const char* a3 = a2 + kstep; const char* b3 = b2 + kstep;
            PG8_LDB(B0, 0, 0); PG8_LDB(B1, 0, 1); PG8_SCHED; PG8_LDA(At, 0, 0); PG8_STAGE(PG8_SA(1, 1), a1 + hstepA, voffA);
            PG8_WAIT_V(8); PG8_WAIT_L(0); PG8_BAR; PG8_MMA(0, 0, At, B0); PG8_MMA(0, 1, At, B1); PG8_BAR; PG8_SCHED;
            PG8_LDA(At, 0, 1); PG8_STAGE(PG8_SB(0, 0), b2, voffB); PG8_STAGE(PG8_SB(0, 1), b2 + hstepB, voffB); PG8_STAGE(PG8_SA(0, 0), a2, voffA);
            PG8_WAIT_V(8); PG8_WAIT_L(0); PG8_BAR; PG8_MMA(1, 0, At, B0); PG8_MMA(1, 1, At, B1); PG8_BAR; PG8_SCHED;
            PG8_LDB(B0, 1, 0); PG8_LDB(B1, 1, 1); PG8_SCHED; PG8_LDA(At, 1, 0); PG8_STAGE(PG8_SA(0, 1), a2 + hstepA, voffA);
            PG8_WAIT_V(8); PG8_WAIT_L(0); PG8_BAR; PG8_MMA(0, 0, At, B0); PG8_MMA(0, 1, At, B1); PG8_BAR; PG8_SCHED;
            PG8_LDA(At, 1, 1); PG8_STAGE(PG8_SB(1, 0), b3, voffB); PG8_STAGE(PG8_SB(1, 1), b3 + hstepB, voffB); PG8_STAGE(PG8_SA(1, 0), a3, voffA);
            PG8_WAIT_V(8); PG8_WAIT_L(0); PG8_BAR; PG8_MMA(1, 0, At, B0); PG8_MMA(1, 1, At, B1); PG8_BAR; PG8_SCHED;
        }
        if constexpr (ALIGN_EPI) { if (wr == 0) PG8_BAR; }
        E(acc, cur, wr, wc, fr, fq);
        if (!has_next) break;
#pragma unroll
        for (int a = 0; a < 2; ++a)
#pragma unroll
            for (int b = 0; b < 2; ++b)
#pragma unroll
                for (int m = 0; m < 4; ++m)
#pragma unroll
                    for (int n = 0; n < 2; ++n) acc[a][b][m][n] = (f32x4){0.f, 0.f, 0.f, 0.f};
        cur = nxt; cA = nA; cB = nB; ++ui;
        if constexpr (ALIGN_EPI) { if (wr == 1) PG8_BAR; }
    }
    PG8_WAIT_V(0);
    if constexpr (!ALIGN_EPI) { if (wr == 0) PG8_BAR; }
    PG8_BAR;
#undef PG8_SA
#undef PG8_SB
#undef PG8_STAGE
#undef PG8_LDA
#undef PG8_LDB
#undef PG8_MMA
#undef PG8_WAIT_V
#undef PG8_WAIT_L
#undef PG8_BAR
#undef PG8_SCHED
}
}

__device__ __forceinline__ void st8bf(bf16_t* p, f32x4 a, f32x4 b) { u32x4 w; w.x = pk2(a[0], a[1]); w.y = pk2(a[2], a[3]); w.z = pk2(b[0], b[1]); w.w = pk2(b[2], b[3]); *(u32x4*)p = w; }
__device__ __forceinline__ f32x4 sig4(f32x4 v) { f32x4 r; r[0] = sigmoidf_(v[0]); r[1] = sigmoidf_(v[1]); r[2] = sigmoidf_(v[2]); r[3] = sigmoidf_(v[3]); return r; }

struct Epi1 {
    static constexpr bool PERM = true;
    bf16_t *U, *AG, *Q, *KS, *KW, *BG; float* G; float* out;
    __device__ __forceinline__ void operator()(const f32x4 (&acc)[2][2][4][2], const pg8::Unit& u, int wr, int wc, int fr, int fq) const {
        const int pn = u.pn, cw = wc * 32 + 8 * fq;
#pragma unroll
        for (int ai = 0; ai < 2; ++ai)
#pragma unroll
            for (int m = 0; m < 4; ++m) {
                const int row = u.pm * 256 + ai * 128 + wr * 64 + m * 16 + fr;
                if (row >= MR) continue;
                const bool smp = row >= MP;
                const int b = smp ? (row - MP) >> 2 : row >> 13, t = smp ? (row - MP) & 3 : row & (SEQ - 1);
                if (pn < 4) {
                    f32x4 v0 = acc[ai][0][m][0] * sig4(acc[ai][1][m][0]), v1 = acc[ai][0][m][1] * sig4(acc[ai][1][m][1]);
                    const int col = pn * 128 + cw;
                    st8bf(U + (size_t)row * 512 + col, v0, v1);
                    float* o = nullptr;
                    if (!smp) { if (t >= SEQ - 30) o = out + O_CONV + ((size_t)b * 30 + (t - (SEQ - 30))) * 512 + col; }
                    else o = out + O_CONVS + ((size_t)b * 30 + 26 + t) * 512 + col;
                    if (o) { *(f32x4*)o = v0; *(f32x4*)(o + 4) = v1; }
                } else if (pn < 6 || pn == 11 || pn == 12) {
                    bf16_t* dst = (pn < 6 ? AG : BG) + (size_t)row * 512 + (pn < 6 ? pn - 4 : pn - 11) * 256 + cw;
#pragma unroll
                    for (int bj = 0; bj < 2; ++bj) { const f32x4 a = acc[ai][bj][m][0], c = acc[ai][bj][m][1]; st8bf(dst + bj * 128, a * sig4(a), c * sig4(c)); }
                } else if (pn < 8) {
                    bf16_t* dst = Q + (size_t)row * 512 + (pn - 6) * 256 + cw;
#pragma unroll
                    for (int bj = 0; bj < 2; ++bj) st8bf(dst + bj * 128, acc[ai][bj][m][0] * C2, acc[ai][bj][m][1] * C2);
                } else if (pn == 8) {
                    float* o = (smp ? out + O_KCS + (size_t)(row - MP) * 256 : out + O_KC + (size_t)row * 256) + cw;
#pragma unroll
                    for (int bj = 0; bj < 2; ++bj) { *(f32x4*)(o + bj * 128) = acc[ai][bj][m][0]; *(f32x4*)(o + bj * 128 + 4) = acc[ai][bj][m][1]; }
                } else if (pn == 9) {
                    float* o = (smp ? out + O_KSS + (size_t)(row - MP) * 256 : out + O_KSEL + (size_t)row * 256) + cw;
                    bf16_t* dst = KS + (size_t)row * 256 + cw;
#pragma unroll
                    for (int bj = 0; bj < 2; ++bj) { *(f32x4*)(o + bj * 128) = acc[ai][bj][m][0]; *(f32x4*)(o + bj * 128 + 4) = acc[ai][bj][m][1]; st8bf(dst + bj * 128, acc[ai][bj][m][0], acc[ai][bj][m][1]); }
                } else if (pn == 10) {
                    float* o = nullptr;
                    if (!smp) { if (t >= SEQ - 512) o = out + O_WIN + ((size_t)b * 512 + (t - (SEQ - 512))) * 256 + cw; }
                    else o = out + O_WINS + ((size_t)b * 512 + 508 + t) * 256 + cw;
                    bf16_t* dst = KW + (size_t)row * 256 + cw;
#pragma unroll
                    for (int bj = 0; bj < 2; ++bj) { st8bf(dst + bj * 128, acc[ai][bj][m][0], acc[ai][bj][m][1]);
                        if (o) { *(f32x4*)(o + bj * 128) = acc[ai][bj][m][0]; *(f32x4*)(o + bj * 128 + 4) = acc[ai][bj][m][1]; } }
                } else {
                    if (wc == 0 && fq < 3) { float* o = G + (size_t)row * 24 + 8 * fq; *(f32x4*)o = sig4(acc[ai][0][m][0]); *(f32x4*)(o + 4) = sig4(acc[ai][0][m][1]); }
                }
            }
    }
};
struct EpiF32 {
    static constexpr bool PERM = false;
    float* O; int ldc;
    __device__ __forceinline__ void operator()(const f32x4 (&acc)[2][2][4][2], const pg8::Unit& u, int wr, int wc, int fr, int fq) const {
#pragma unroll
        for (int ai = 0; ai < 2; ++ai)
#pragma unroll
            for (int m = 0; m < 4; ++m) {
                const int row = u.pm * 256 + ai * 128 + wr * 64 + m * 16 + fr;
                if (row >= MR) continue;
                float* o = O + (size_t)row * ldc + u.pn * 256 + wc * 32 + 4 * fq;
#pragma unroll
                for (int bj = 0; bj < 2; ++bj)
#pragma unroll
                    for (int n = 0; n < 2; ++n) *(f32x4*)(o + bj * 128 + n * 16) = acc[ai][bj][m][n];
            }
    }
};
struct Epi3 {
    static constexpr bool PERM = true;
    bf16_t *V, *GT; float* out;
    __device__ __forceinline__ void operator()(const f32x4 (&acc)[2][2][4][2], const pg8::Unit& u, int wr, int wc, int fr, int fq) const {
        const int pn = u.pn, cw = wc * 32 + 8 * fq;
#pragma unroll
        for (int ai = 0; ai < 2; ++ai)
#pragma unroll
            for (int m = 0; m < 4; ++m) {
                const int row = u.pm * 256 + ai * 128 + wr * 64 + m * 16 + fr;
                if (row >= MR) continue;
                const bool smp = row >= MP;
                const int b = smp ? (row - MP) >> 2 : row >> 13, t = smp ? (row - MP) & 3 : row & (SEQ - 1);
                if (pn < 4) {
                    const int col = pn * 256 + cw;
                    float* o = nullptr;
                    if (!smp) { if (t >= SEQ - 15) o = out + O_POOL + ((size_t)b * 15 + (t - (SEQ - 15))) * 1024 + col; }
                    else o = out + O_POOLS + ((size_t)b * 15 + 11 + t) * 1024 + col;
#pragma unroll
                    for (int bj = 0; bj < 2; ++bj) { st8bf(V + (size_t)row * 1024 + col + bj * 128, acc[ai][bj][m][0], acc[ai][bj][m][1]);
                        if (o) { *(f32x4*)(o + bj * 128) = acc[ai][bj][m][0]; *(f32x4*)(o + bj * 128 + 4) = acc[ai][bj][m][1]; } }
                } else {
                    bf16_t* dst = GT + (size_t)row * 1024 + (pn - 4) * 256 + cw;
#pragma unroll
                    for (int bj = 0; bj < 2; ++bj) { const f32x4 a = acc[ai][bj][m][0], c = acc[ai][bj][m][1]; st8bf(dst + bj * 128, a * sig4(a), c * sig4(c)); }
                }
            }
    }
};
struct Epi4 {
    static constexpr bool PERM = true;
    const bf16_t* GT; const float* scale; bf16_t* MX;
    __device__ __forceinline__ void operator()(const f32x4 (&acc)[2][2][4][2], const pg8::Unit& u, int wr, int wc, int fr, int fq) const {
        const int cw = u.pn * 256 + wc * 32 + 8 * fq;
#pragma unroll
        for (int ai = 0; ai < 2; ++ai)
#pragma unroll
            for (int m = 0; m < 4; ++m) {
                const int row = u.pm * 256 + ai * 128 + wr * 64 + m * 16 + fr;
                if (row >= MR) continue;
#pragma unroll
                for (int bj = 0; bj < 2; ++bj) {
                    const int col = cw + bj * 128;
                    const u32x4 gw = *(const u32x4*)(GT + (size_t)row * 1024 + col);
                    const f32x4 s0 = *(const f32x4*)(scale + col), s1 = *(const f32x4*)(scale + col + 4);
                    f32x4 a = acc[ai][bj][m][0] * s0, c = acc[ai][bj][m][1] * s1;
                    a[0] *= bflo(gw.x); a[1] *= bfhi(gw.x); a[2] *= bflo(gw.y); a[3] *= bfhi(gw.y);
                    c[0] *= bflo(gw.z); c[1] *= bfhi(gw.z); c[2] *= bflo(gw.w); c[3] *= bfhi(gw.w);
                    st8bf(MX + (size_t)row * 1024 + col, a, c);
                }
            }
    }
};
#define XB_TMO      128
#define XB_XCNT(j)  (256  + 64 * (j))
#define XB_XSUB(j)  (1280 + 64 * (j))
#define XB_XGEN(j)  (2304 + 64 * (j))
#define XB_TOP      3328
#define XB_TOPGEN   3392
#define XCD_BAR_WORDS 3456
#define XB_SPIN_CAP (1u << 18)

__device__ __forceinline__ unsigned xb_ld(unsigned* p)              { return __hip_atomic_load(p, __ATOMIC_RELAXED, __HIP_MEMORY_SCOPE_AGENT); }
__device__ __forceinline__ unsigned xb_add(unsigned* p, unsigned v) { return __hip_atomic_fetch_add(p, v, __ATOMIC_RELAXED, __HIP_MEMORY_SCOPE_AGENT); }
__device__ __forceinline__ unsigned xb_xcc_id() { return (unsigned)__builtin_amdgcn_s_getreg((3 << 11) | 20) & 0xFu; }
#define XB_SPIN(cond, bar) do { unsigned _sp = 0; while (cond) { __builtin_amdgcn_s_sleep(1); \
    if ((++_sp & 255u) == 0u) { if (xb_ld(&(bar)[XB_TMO])) break; if (_sp > XB_SPIN_CAP) { atomicAdd(&(bar)[XB_TMO], 1u); break; } } } } while (0)

struct XcdBarrier {
    unsigned* bar; unsigned x;
    volatile LAS unsigned* st;
};

__device__ __forceinline__ XcdBarrier xcd_barrier_post(unsigned* bar, volatile LAS unsigned* st) {
    XcdBarrier b; b.bar = bar; b.x = xb_xcc_id(); b.st = st;
    if (threadIdx.x == 0) (void)xb_add(&bar[XB_XCNT(b.x)], 1u);
    return b;
}
__device__ __forceinline__ void xcd_barrier_complete(unsigned* bar, unsigned x, unsigned& nloc, unsigned& nx) {
    const unsigned G = gridDim.x * gridDim.y * gridDim.z;
    unsigned sum, cnt, mine, sp = 0u;
    for (;;) {
        sum = 0u; cnt = 0u; mine = 0u;
#pragma unroll
        for (unsigned j = 0; j < 16; ++j) { const unsigned c = xb_ld(&bar[XB_XCNT(j)]); sum += c; cnt += (c > 0u) ? 1u : 0u; mine = (j == x) ? c : mine; }
        if (sum == G) break;
        __builtin_amdgcn_s_sleep(1);
        if ((++sp & 255u) == 0u) { if (xb_ld(&bar[XB_TMO])) break; if (sp > XB_SPIN_CAP) { atomicAdd(&bar[XB_TMO], 1u); break; } }
    }
    nloc = mine > 0u ? mine : 1u; nx = cnt > 0u ? cnt : 1u;
}

__device__ __forceinline__ void xcd_barrier(const XcdBarrier& b) {
    asm volatile("s_waitcnt vmcnt(0)" ::: "memory");
    __syncthreads();
    if (threadIdx.x == 0) {
        unsigned* bar = b.bar;
        __builtin_amdgcn_s_waitcnt(0);
        unsigned nloc = b.st[0], nx = b.st[1];
        if (nloc == 0u) { xcd_barrier_complete(bar, b.x, nloc, nx); b.st[0] = nloc; b.st[1] = nx; }
        const unsigned old = xb_add(&bar[XB_XSUB(b.x)], 1u);
        const unsigned gen = old / nloc;
        if (old + 1u == (gen + 1u) * nloc) {
            __builtin_amdgcn_fence(__ATOMIC_RELEASE, "agent");
            asm volatile("s_waitcnt vmcnt(0)" ::: "memory");
            const unsigned og = xb_add(&bar[XB_TOP], 1u);
            const unsigned tg = og / nx;
            if (og + 1u == (tg + 1u) * nx) xb_add(&bar[XB_TOPGEN], 1u);
            else XB_SPIN(xb_ld(&bar[XB_TOPGEN]) == tg, bar);
            __builtin_amdgcn_fence(__ATOMIC_ACQUIRE, "agent");
            xb_add(&bar[XB_XGEN(b.x)], 1u);
            asm volatile("s_waitcnt vmcnt(0)" ::: "memory");
        } else {
            XB_SPIN(xb_ld(&bar[XB_XGEN(b.x)]) == gen, bar);
            __builtin_amdgcn_fence(__ATOMIC_ACQUIRE, "agent");
            asm volatile("s_waitcnt vmcnt(0)" ::: "memory");
        }
    }
    __syncthreads();
}

struct Ctx { LAS unsigned char* lds; int tid, lane, wave, G, bid; };

__device__ __forceinline__ int w1_src_col(int blk) {
    const int p = blk >> 3, r = (blk & 7) * 32;
    if (p < 4) return r < 128 ? 128 * p + r : 512 + 128 * p + (r - 128);
    if (p < 6) return 1024 + 256 * (p - 4) + r;
    if (p < 8) return 1536 + 256 * (p - 6) + r;
    if (p == 8) return 2048 + r;
    if (p == 9) return 2304 + r;
    if (p == 10) return 2560 + r;
    if (p < 13) return 2840 + 256 * (p - 11) + r;
    return r == 0 ? 2816 : -1;
}
__device__ __forceinline__ void p0_transpose_item(const float* W, int Nsrc, bf16_t* WT, int Kdst, int k0, int src_col0, int dst_row0, LAS float* scr, int lane) {
#pragma unroll 8
    for (int i = 0; i < 32; ++i) { const int kk = 2 * i + (lane >> 5); scr[kk * 33 + (lane & 31)] = (src_col0 >= 0) ? W[(size_t)(k0 + kk) * Nsrc + src_col0 + (lane & 31)] : 0.f; }
    LDS_WAIT();
    const int c = lane & 7;
#pragma unroll
    for (int j = 0; j < 4; ++j) { const int n = (lane >> 3) + 8 * j; const LAS float* s = scr + (8 * c) * 33 + n;
        u32x4 o; o.x = pk2(s[0 * 33], s[1 * 33]); o.y = pk2(s[2 * 33], s[3 * 33]); o.z = pk2(s[4 * 33], s[5 * 33]); o.w = pk2(s[6 * 33], s[7 * 33]);
        *(u32x4*)(WT + (size_t)(dst_row0 + n) * Kdst + k0 + 8 * c) = o; }
    LDS_WAIT();
}
template <class RowPtr>
__device__ __forceinline__ void compress_task(const RowPtr& rp, int nrows, int p, const LAS float* wl, bf16_t* dst, int nmax, int lane) {
    f32x4 Aprev = (f32x4){0.f, 0.f, 0.f, 0.f};
    for (int i = 0; i <= 8; ++i) {
        const int r0 = 128 * p + 16 * i;
        if (r0 >= nrows) break;
        f32x4 v[16];
#pragma unroll
        for (int j = 0; j < 16; ++j) v[j] = __builtin_nontemporal_load((const f32x4*)(rp(r0 + j)) + lane);
        f32x4 A = (f32x4){0.f, 0.f, 0.f, 0.f}, B = A;
#pragma unroll
        for (int j = 0; j < 16; ++j) { const f32x4 wa = *(const LAS f32x4*)(wl + j * 256 + 4 * lane), wb = *(const LAS f32x4*)(wl + (16 + j) * 256 + 4 * lane); A += v[j] * wa; B += v[j] * wb; }
        if (i >= 1) { const int n = 8 * p + i - 1; if (n < nmax) { const f32x4 s = Aprev + B; u32x2 o; o.x = pk2(s[0], s[1]); o.y = pk2(s[2], s[3]); *(u32x2*)(dst + (size_t)n * 256 + 4 * lane) = o; } }
        Aprev = A;
    }
}
struct RowsPaged { const float* cache; const int* pt; __device__ __forceinline__ const float* operator()(int r) const { return cache + ((size_t)pt[r >> 7] * PAGE + (r & (PAGE - 1))) * 256; } };
struct RowsFlat { const float* base; __device__ __forceinline__ const float* operator()(int r) const { return base + (size_t)r * 256; } };

__device__ __forceinline__ void load_wcmp(const Prm& P, Ctx& C, LAS float* wl) { for (int i = C.tid; i < 32 * 256 / 4; i += NTHR) ((LAS f32x4*)wl)[i] = ((const f32x4*)P.w_cmp)[i]; }

__device__ __forceinline__ void phase_prologue(const Prm& P, Ctx& C) {
    unsigned char* ws = P.ws;
    const int gw = C.bid * NWAVES + C.wave, NGW = C.G * NWAVES;
    LAS float* wl = (LAS float*)(C.lds + 73728);
    load_wcmp(P, C, wl);
    __syncthreads();
    bf16_t* KCS = (bf16_t*)(ws + WS_KCS);
    for (int tk = gw; tk < DB * NPAGES; tk += NGW) {
        const int b = tk >> 7, p = tk & 127;
        RowsPaged rp{P.cache_c, P.page_table + b * NPAGES};
        compress_task(rp, PAST, p, wl, KCS + (size_t)b * 1024 * 256, 1023, C.lane);
        if (p == 127) *(u32x2*)(KCS + ((size_t)b * 1024 + 1023) * 256 + 4 * C.lane) = (u32x2){0u, 0u};
    }
    LAS float* scr = (LAS float*)(C.lds + C.wave * 8704);
    for (int it = gw; it < 3968; it += NGW) {
        int r = it;
        if (r < 1792) { const int blk = r >> 4, kb = r & 15; p0_transpose_item(P.w_in_even, E_IN, (bf16_t*)(ws + WS_W1T), 1024, 64 * kb, w1_src_col(blk), 32 * blk, scr, C.lane); continue; } r -= 1792;
        if (r < 512) { const int blk = r >> 4, kb = r & 15; p0_transpose_item(P.w_out_even, 1024, (bf16_t*)(ws + WS_W2T), 1024, 64 * kb, 32 * blk, 32 * blk, scr, C.lane); continue; } r -= 512;
        if (r < 1024) { const int blk = r >> 4, kb = r & 15; p0_transpose_item(P.w_in_odd, 2048, (bf16_t*)(ws + WS_W3T), 1024, 64 * kb, 32 * blk, 32 * blk, scr, C.lane); continue; } r -= 1024;
        if (r < 128) { const int g = r >> 5, rr = r & 31, blk = rr >> 2, kb = rr & 3; p0_transpose_item(P.w_grp + g * 65536, 256, (bf16_t*)(ws + WS_W4T) + g * 65536, 256, 64 * kb, 32 * blk, 32 * blk, scr, C.lane); continue; } r -= 128;
        { const int blk = r >> 4, kb = r & 15; p0_transpose_item(P.w_out_odd, 1024, (bf16_t*)(ws + WS_W5T), 1024, 64 * kb, 32 * blk, 32 * blk, scr, C.lane); }
    }
    bf16_t* XA = (bf16_t*)(ws + WS_XA);
    for (int m = gw; m < MA; m += NGW) {
        const float* src = m < MP ? P.x_prompt + (size_t)m * DM : (m < MR ? P.x_sample + (size_t)(m - MP) * DM : nullptr);
#pragma unroll
        for (int j = 0; j < 4; ++j) { f32x4 v = src ? *(const f32x4*)(src + 4 * C.lane + 256 * j) : (f32x4){0.f, 0.f, 0.f, 0.f};
            u32x2 o; o.x = pk2(v[0], v[1]); o.y = pk2(v[2], v[3]); *(u32x2*)(XA + (size_t)m * DM + 4 * C.lane + 256 * j) = o; }
    }
    const int gt = C.bid * NTHR + C.tid, NGT = C.G * NTHR;
    for (int i = gt; i < DB * 508 * 64; i += NGT) { const int b = i / (508 * 64), r = i % (508 * 64); ((f32x4*)(P.out + O_WINS + (size_t)b * 512 * 256))[r] = ((const f32x4*)(P.state_win + ((size_t)b * 512 + 4) * 256))[r]; }
    for (int i = gt; i < DB * 26 * 128; i += NGT) { const int b = i / (26 * 128), r = i % (26 * 128); ((f32x4*)(P.out + O_CONVS + (size_t)b * 30 * 512))[r] = ((const f32x4*)(P.state_conv + ((size_t)b * 30 + 4) * 512))[r]; }
    for (int i = gt; i < DB * 11 * 256; i += NGT) { const int b = i / (11 * 256), r = i % (11 * 256); ((f32x4*)(P.out + O_POOLS + (size_t)b * 15 * 1024))[r] = ((const f32x4*)(P.state_pool + ((size_t)b * 15 + 4) * 1024))[r]; }
    for (int i = gt; i < (MA - MR) * 1024 / 8; i += NGT) ((u32x4*)(ws + WS_H2 + (size_t)MR * 1024 * 2))[i] = (u32x4){0u, 0u, 0u, 0u};
}

template <int NT, bool SMP>
__device__ __forceinline__ void conv_body(const Prm& P, Ctx& C, int b, int t0) {
    const int c = C.tid;
    const bf16_t* U = (const bf16_t*)(P.ws + WS_U);
    const int row0 = SMP ? MP + 4 * b : b * SEQ + t0;
    float uu[30 + NT];
#pragma unroll
    for (int i = 0; i < 30 + NT; ++i) {
        if (SMP) uu[i] = i < 30 ? P.state_conv[((size_t)b * 30 + i) * 512 + c] : bf2f(U[(size_t)(row0 + i - 30) * 512 + c]);
        else { const int ti = t0 - 30 + i; uu[i] = ti >= 0 ? bf2f(U[(size_t)(row0 + i - 30) * 512 + c]) : 0.f; }
    }
    float w[31];
#pragma unroll
    for (int k = 0; k < 31; ++k) w[k] = P.conv_w[k * 512 + c];
    const float bias = P.conv_b[c];
    LAS float* y = (LAS float*)C.lds;
#pragma unroll
    for (int i = 0; i < NT; ++i) { float a = bias;
#pragma unroll
        for (int k = 0; k < 31; ++k) a += w[k] * uu[i + k];
        y[i * 512 + c] = a; }
    __syncthreads();
    const bf16_t* AG = (const bf16_t*)(P.ws + WS_AG); bf16_t* H2 = (bf16_t*)(P.ws + WS_H2);
    for (int i = C.wave; i < NT; i += NWAVES) {
        float v[8], s = 0.f;
#pragma unroll
        for (int j = 0; j < 8; ++j) { v[j] = y[i * 512 + C.lane + 64 * j]; s += v[j]; }
        const float mean = wave_sum(s) * (1.f / 512.f); float q = 0.f;
#pragma unroll
        for (int j = 0; j < 8; ++j) { v[j] -= mean; q += v[j] * v[j]; }
        const float rstd = 1.f / sqrtf(wave_sum(q) * (1.f / 512.f) + LN_EPS);
        const size_t row = (size_t)(row0 + i);
#pragma unroll
        for (int j = 0; j < 8; ++j) { const int cc = C.lane + 64 * j; float z = v[j] * rstd * P.conv_ln_g[cc] + P.conv_ln_b[cc]; z = siluf_(z) * bf2f(AG[row * 512 + cc]); H2[row * 1024 + cc] = (bf16_t)f2bf(z); }
    }
    __syncthreads();
}
__device__ __forceinline__ void phase_conv(const Prm& P, Ctx& C) {
    LAS float* wl = (LAS float*)(C.lds + 73728);
    load_wcmp(P, C, wl);
    __syncthreads();
    for (int un = C.bid; un < 1024 + DB; un += C.G) {
        if (un < 1024) conv_body<32, false>(P, C, un >> 8, (un & 255) * 32);
        else conv_body<4, true>(P, C, un - 1024, 0);
    }
    const int gw = C.bid * NWAVES + C.wave, NGW = C.G * NWAVES;
    bf16_t* KC = (bf16_t*)(P.ws + WS_KC);
    for (int tk = gw; tk < NBATCH * 64; tk += NGW) {
        const int b = tk >> 6, p = tk & 63;
        RowsFlat rp{P.out + O_KC + (size_t)b * SEQ * 256};
        compress_task(rp, SEQ, p, wl, KC + (size_t)b * 512 * 256, 511, C.lane);
        if (p == 63) *(u32x2*)(KC + ((size_t)b * 512 + 511) * 256 + 4 * C.lane) = (u32x2){0u, 0u};
    }
}

template <int LAYER>
__device__ __forceinline__ void phase_ln(const Prm& P, Ctx& C) {
    const int gw = C.bid * NWAVES + C.wave, NGW = C.G * NWAVES;
    const float* dp = (const float*)(P.ws + (LAYER == 0 ? WS_DP : WS_DP2));
    const float* gam = P.ln_g + LAYER * DM; const float* bet = P.ln_b + LAYER * DM;
    for (int m = gw; m < MR; m += NGW) {
        const float* xin = LAYER == 0 ? (m < MP ? P.x_prompt + (size_t)m * DM : P.x_sample + (size_t)(m - MP) * DM) : (const float*)(P.ws + WS_X1) + (size_t)m * DM;
        float* of = LAYER == 0 ? (float*)(P.ws + WS_X1) + (size_t)m * DM : (m < MP ? P.out + O_Y + (size_t)m * DM : P.out + O_YS + (size_t)(m - MP) * DM);
        f32x4 v[4]; float s = 0.f;
#pragma unroll
        for (int j = 0; j < 4; ++j) { const f32x4 a = *(const f32x4*)(xin + 4 * C.lane + 256 * j), d = *(const f32x4*)(dp + (size_t)m * DM + 4 * C.lane + 256 * j); v[j] = a * ALPHA + d; s += (v[j][0] + v[j][1]) + (v[j][2] + v[j][3]); }
        const float mean = wave_sum(s) * (1.f / DM); float q = 0.f;
#pragma unroll
        for (int j = 0; j < 4; ++j) { v[j] = v[j] - mean; q += (v[j][0] * v[j][0] + v[j][1] * v[j][1]) + (v[j][2] * v[j][2] + v[j][3] * v[j][3]); }
        const float rstd = 1.f / sqrtf(wave_sum(q) * (1.f / DM) + LN_EPS);
#pragma unroll
        for (int j = 0; j < 4; ++j) { const f32x4 gg = *(const f32x4*)(gam + 4 * C.lane + 256 * j), bb = *(const f32x4*)(bet + 4 * C.lane + 256 * j); const f32x4 o = v[j] * rstd * gg + bb;
            *(f32x4*)(of + 4 * C.lane + 256 * j) = o;
            if (LAYER == 0) { u32x2 w; w.x = pk2(o[0], o[1]); w.y = pk2(o[2], o[3]); *(u32x2*)((bf16_t*)(P.ws + WS_X1A) + (size_t)m * DM + 4 * C.lane + 256 * j) = w; } }
    }
}

__device__ __forceinline__ void phase_pool(const Prm& P, Ctx& C) {
    const bf16_t* V = (const bf16_t*)(P.ws + WS_V); bf16_t* D = (bf16_t*)(P.ws + WS_DM);
    const int gt = C.bid * NTHR + C.tid, NGT = C.G * NTHR;
    for (int i = gt; i < MR * 128; i += NGT) {
        const int row = i >> 7, c0 = (i & 127) * 8, w = 2 << (c0 >> 8);
        float s[8];
#pragma unroll
        for (int e = 0; e < 8; ++e) s[e] = 0.f;
        float cnt;
        if (row < MP) {
            const int t = row & (SEQ - 1); const int nk = t + 1 < w ? t + 1 : w; cnt = (float)nk;
            for (int k = 0; k < nk; ++k) { const u32x4 x = *(const u32x4*)(V + (size_t)(row - k) * 1024 + c0);
                s[0] += bflo(x.x); s[1] += bfhi(x.x); s[2] += bflo(x.y); s[3] += bfhi(x.y); s[4] += bflo(x.z); s[5] += bfhi(x.z); s[6] += bflo(x.w); s[7] += bfhi(x.w); }
        } else {
            const int b = (row - MP) >> 2, ts = (row - MP) & 3; cnt = (float)w;
            for (int k = 0; k < w; ++k) { const int e = 15 + ts - k;
                if (e >= 15) { const u32x4 x = *(const u32x4*)(V + (size_t)(MP + 4 * b + e - 15) * 1024 + c0);
                    s[0] += bflo(x.x); s[1] += bfhi(x.x); s[2] += bflo(x.y); s[3] += bfhi(x.y); s[4] += bflo(x.z); s[5] += bfhi(x.z); s[6] += bflo(x.w); s[7] += bfhi(x.w); }
                else { const float* sp = P.state_pool + ((size_t)b * 15 + e) * 1024 + c0; const f32x4 a = *(const f32x4*)sp, d = *(const f32x4*)(sp + 4);
                    s[0] += a[0]; s[1] += a[1]; s[2] += a[2]; s[3] += a[3]; s[4] += d[0]; s[5] += d[1]; s[6] += d[2]; s[7] += d[3]; } }
        }
        const u32x4 x = *(const u32x4*)(V + (size_t)row * 1024 + c0); const float inv = 1.f / cnt;
        u32x4 o; o.x = pk2(s[0] * inv - bflo(x.x), s[1] * inv - bfhi(x.x)); o.y = pk2(s[2] * inv - bflo(x.y), s[3] * inv - bfhi(x.y));
        o.z = pk2(s[4] * inv - bflo(x.z), s[5] * inv - bfhi(x.z)); o.w = pk2(s[6] * inv - bflo(x.w), s[7] * inv - bfhi(x.w));
        *(u32x4*)(D + (size_t)row * 1024 + c0) = o;
    }
}

#define MFMA32(a, b, c) __builtin_amdgcn_mfma_f32_32x32x16_bf16((a), (b), (c), 0, 0, 0)
__device__ __forceinline__ bf16x8 pack8(const f32x16& p, int base) {
    u32x4 w; w.x = pk2(p[base + 0], p[base + 1]); w.y = pk2(p[base + 2], p[base + 3]); w.z = pk2(p[base + 4], p[base + 5]); w.w = pk2(p[base + 6], p[base + 7]);
    return __builtin_bit_cast(bf16x8, w);
}

template <int NBL>
__device__ __forceinline__ unsigned topk_select(const LAS float* sc  , int sub, int cur) {
    unsigned v[NBL]; unsigned candm = 0u, forced = 0u;
#pragma unroll
    for (int e = 0; e < NBL; ++e) { const int j = sub * NBL + e; const bool cand = (j >= 1) && (j <= cur - 2);
        v[e] = cand ? __float_as_uint(sc[j]) : 0u; if (cand) candm |= 1u << e;
        if (j == 0 || j == cur || (j == cur - 1 && cur >= 1)) forced |= 1u << e; }
    const int nf = cur == 0 ? 1 : (cur == 1 ? 2 : 3), kk = 16 - nf, ncand = cur - 2 > 0 ? cur - 2 : 0;
    unsigned prefix = 0u;
    for (int bit = 30; bit >= 0; --bit) {
        const unsigned trial = prefix | (1u << bit); int cnt = 0;
#pragma unroll
        for (int e = 0; e < NBL; ++e) cnt += (v[e] >= trial) ? 1 : 0;
        cnt += __shfl_xor(cnt, 1); cnt += __shfl_xor(cnt, 2); cnt += __shfl_xor(cnt, 4);
        if (cnt >= kk) prefix = trial;
    }
    unsigned gt = 0u, eq = 0u;
#pragma unroll
    for (int e = 0; e < NBL; ++e) { if ((candm >> e) & 1u) { if (v[e] > prefix) gt |= 1u << e; else if (v[e] == prefix) eq |= 1u << e; } }
    int ngt = __popc(gt); ngt += __shfl_xor(ngt, 1); ngt += __shfl_xor(ngt, 2); ngt += __shfl_xor(ngt, 4);
    const int eqc = __popc(eq); int inc = eqc;
    { int t1 = __shfl_up(inc, 1, 8); if (sub >= 1) inc += t1; t1 = __shfl_up(inc, 2, 8); if (sub >= 2) inc += t1; t1 = __shfl_up(inc, 4, 8); if (sub >= 4) inc += t1; }
    int take = (kk - ngt) - (inc - eqc); take = take < 0 ? 0 : (take > eqc ? eqc : take);
    unsigned seleq = 0u, tmp = eq;
    for (int i = 0; i < take; ++i) { const unsigned low = tmp & (0u - tmp); seleq |= low; tmp ^= low; }
    const unsigned sel = (ncand <= kk) ? candm : (gt | seleq);
    return sel | forced;
}

template <bool SMP>
__device__ __forceinline__ void cmp_wave_task(const Prm& P, int task, LAS float* sc, int lane) {
    constexpr int NBLK = SMP ? 256 : 128, NBL = NBLK / 8;
    const int q = lane & 31, hi = lane >> 5, slot = q >> 2, g = q & 3;
    int b, kvh, tg = 0;
    if (SMP) { b = task >> 1; kvh = task & 1; } else { const int bk = task >> 10; tg = task & 1023; b = bk >> 1; kvh = bk & 1; }
    const int tok = SMP ? (slot < 3 ? slot : 3) : 8 * tg + slot;
    const size_t row = SMP ? (size_t)(MP + 4 * b + tok) : (size_t)b * SEQ + tok;
    const int head = 4 * kvh + g;
    const int nvq = SMP ? 1023 : (tok >= 31 ? ((tok - 31) >> 4) + 1 : 0);
    const int tlast = 8 * tg + 7;
    const int nvmax = SMP ? 1023 : (tlast >= 31 ? ((tlast - 31) >> 4) + 1 : 0);
    const int ntile = (nvmax + 31) >> 5;
    const bf16_t* Kb = SMP ? (const bf16_t*)(P.ws + WS_KCS) + (size_t)b * 1024 * 256 + kvh * 64 : (const bf16_t*)(P.ws + WS_KC) + (size_t)b * 512 * 256 + kvh * 64;
    const bf16_t* Vb = Kb + 128;
    const bf16_t* Qp = (const bf16_t*)(P.ws + WS_Q) + row * 512 + head * 64 + 8 * hi;
    bf16x8 qf[4];
#pragma unroll
    for (int s = 0; s < 4; ++s) qf[s] = *(const bf16x8*)(Qp + 16 * s);
    float m = NEGB, l = 0.f;
    for (int tile = 0; tile < ntile; ++tile) {
        const bf16_t* kp = Kb + (size_t)(32 * tile + q) * 256 + 8 * hi;
        f32x16 S = {};
#pragma unroll
        for (int s = 0; s < 4; ++s) S = MFMA32(*(const bf16x8*)(kp + 16 * s), qf[s], S);
        float tmax = NEGB;
#pragma unroll
        for (int r = 0; r < 16; ++r) { const bool valid = (32 * tile + crow(r, hi)) < nvq; S[r] = valid ? S[r] : NEGB; tmax = fmaxf(tmax, S[r]); }
        const float mn = fmaxf(m, tmax); float ps = 0.f;
#pragma unroll
        for (int r = 0; r < 16; ++r) ps += (S[r] > -1e29f) ? ex2(S[r] - mn) : 0.f;
        l = l * ex2(m - mn) + ps; m = mn;
    }
    { const float mo = __shfl_xor(m, 32), lo = __shfl_xor(l, 32); const float M = fmaxf(m, mo); l = l * ex2(m - M) + lo * ex2(mo - M); m = M; }
    const float invl = l > 0.f ? 1.f / l : 0.f;
    for (int i = lane; i < 8 * NBLK; i += 64) sc[i] = 0.f;
    LDS_WAIT();
    f32x16 o[2]; o[0] = f32x16{}; o[1] = f32x16{};
    for (int tile = 0; tile < ntile; ++tile) {
        const bf16_t* kp = Kb + (size_t)(32 * tile + q) * 256 + 8 * hi;
        f32x16 S = {};
#pragma unroll
        for (int s = 0; s < 4; ++s) S = MFMA32(*(const bf16x8*)(kp + 16 * s), qf[s], S);
#pragma unroll
        for (int r = 0; r < 16; ++r) { const bool valid = (32 * tile + crow(r, hi)) < nvq; S[r] = valid ? ex2(S[r] - m) * invl : 0.f; }
#pragma unroll
        for (int i = 0; i < 4; ++i) { float v = S[4 * i] + S[4 * i + 1] + S[4 * i + 2]; v += __shfl_xor(v, 1); v += __shfl_xor(v, 2); if (g == 0) sc[slot * NBLK + 8 * tile + 2 * i + hi] = v; }
        bf16x8 pf[2]; pf[0] = pack8(S, 0); pf[1] = pack8(S, 8);
#pragma unroll
        for (int dblk = 0; dblk < 2; ++dblk)
#pragma unroll
            for (int ks = 0; ks < 2; ++ks) {
                bf16x8 vf;
#pragma unroll
                for (int e = 0; e < 8; ++e) vf[e] = (short)Vb[(size_t)(32 * tile + 16 * ks + 8 * (e >> 2) + 4 * hi + (e & 3)) * 256 + 32 * dblk + q];
                o[dblk] = MFMA32(vf, pf[ks], o[dblk]);
            }
    }
    if (!SMP || slot < 4) {
        const float gate = ((const float*)(P.ws + WS_G))[row * 24 + head * 3 + 0];
        bf16_t* op = (bf16_t*)(P.ws + WS_OC) + row * 512 + head * 64;
#pragma unroll
        for (int dblk = 0; dblk < 2; ++dblk)
#pragma unroll
            for (int i = 0; i < 4; ++i) { u32x2 w; w.x = pk2(o[dblk][4 * i] * gate, o[dblk][4 * i + 1] * gate); w.y = pk2(o[dblk][4 * i + 2] * gate, o[dblk][4 * i + 3] * gate);
                *(u32x2*)(op + 32 * dblk + 8 * i + 4 * hi) = w; }
    }
    LDS_WAIT();
    {
        const int slot2 = lane >> 3, sub = lane & 7;
        const int tok2 = SMP ? (slot2 < 3 ? slot2 : 3) : 8 * tg + slot2;
        const int cur = SMP ? 256 : tok2 >> 6;
        unsigned bits = topk_select<NBL>(sc + slot2 * NBLK, sub, cur);
        if (SMP) { if (slot2 < 4) ((unsigned*)(P.ws + WS_SELMS))[((size_t)(4 * b + slot2) * 2 + kvh) * 8 + sub] = bits; }
        else { bits = (sub & 1) ? bits << 16 : bits; bits |= __shfl_xor(bits, 1);
            if (!(sub & 1)) ((unsigned*)(P.ws + WS_SELM))[(((size_t)b * SEQ + tok2) * 2 + kvh) * 4 + (sub >> 1)] = bits; }
    }
    LDS_WAIT();
}
__device__ __forceinline__ void phase_cmp(const Prm& P, Ctx& C) {
    LAS float* sc = (LAS float*)(C.lds + C.wave * 8192);
    const int gw = C.bid * NWAVES + C.wave, NGW = C.G * NWAVES;
    int it = 0;
    for (int task = gw; task < 8192; task += NGW, ++it) {
        const int tg = task & 1023; const int t2 = (task & ~1023) | ((it & 1) ? 1023 - tg : tg);
        cmp_wave_task<false>(P, t2, sc, C.lane);
    }
    if (gw < 64) cmp_wave_task<true>(P, gw, sc, C.lane);
}

__device__ __forceinline__ void attn_unit_v1(const Prm& P, Ctx& C, int b, int kvh, int tb) {
    LAS bf16_t* Kt = (LAS bf16_t*)C.lds;
    LAS bf16_t* Vt = (LAS bf16_t*)(C.lds + 9216);
    const int lane = C.lane, q = lane & 31, hi = lane >> 5, g = q & 3;
    const int tok = 64 * tb + 8 * C.wave + (q >> 2), head = 4 * kvh + g;
    const size_t row = (size_t)b * SEQ + tok;
    const bf16_t* Qp = (const bf16_t*)(P.ws + WS_Q) + row * 512 + head * 64 + 8 * hi;
    bf16x8 qf[4];
#pragma unroll
    for (int s = 0; s < 4; ++s) qf[s] = *(const bf16x8*)(Qp + 16 * s);
    const u32x4 selm = *(const u32x4*)((const unsigned*)(P.ws + WS_SELM) + (row * 2 + kvh) * 4);
    f32x16 ow[2]; ow[0] = f32x16{}; ow[1] = f32x16{};
    f32x16 o[2];
    const int lkey = C.tid >> 3, lch = C.tid & 7;
#pragma unroll 1
    for (int br = 0; br < 2; ++br) {
        const bf16_t* src = (const bf16_t*)(P.ws + (br == 0 ? WS_KW : WS_KS)) + (size_t)b * SEQ * 256 + kvh * 64;
        float m = NEGB, l = 0.f; o[0] = f32x16{}; o[1] = f32x16{};
        const int kb_lo = br == 0 ? (tb > 8 ? tb - 8 : 0) : 0;
#pragma unroll 1
        for (int kb = kb_lo; kb <= tb; ++kb) {
            __syncthreads();
            { const bf16_t* rp = src + (size_t)(64 * kb + lkey) * 256 + 8 * lch;
              const u32x4 kv = *(const u32x4*)rp, vv = *(const u32x4*)(rp + 128);
              *(LAS u32x4*)(Kt + lkey * 72 + 8 * lch) = kv;
              const unsigned vw[4] = {vv.x, vv.y, vv.z, vv.w};
#pragma unroll
              for (int e = 0; e < 4; ++e) { Vt[(8 * lch + 2 * e) * 72 + lkey] = (bf16_t)(vw[e] & 0xffffu); Vt[(8 * lch + 2 * e + 1) * 72 + lkey] = (bf16_t)(vw[e] >> 16); } }
            __syncthreads();
            const bool sel = br == 0 ? true : (((kb < 32 ? selm.x : kb < 64 ? selm.y : kb < 96 ? selm.z : selm.w) >> (kb & 31)) & 1u) != 0u;
            if (!__any(sel)) continue;
            f32x16 p0 = {}, p1 = {};
#pragma unroll
            for (int s = 0; s < 4; ++s) { const bf16x8 k0 = *(const LAS bf16x8*)(Kt + q * 72 + 16 * s + 8 * hi), k1 = *(const LAS bf16x8*)(Kt + (32 + q) * 72 + 16 * s + 8 * hi);
                p0 = MFMA32(k0, qf[s], p0); p1 = MFMA32(k1, qf[s], p1); }
            float tmax = NEGB;
#pragma unroll
            for (int r = 0; r < 16; ++r) { const int k0 = 64 * kb + crow(r, hi), k1 = k0 + 32;
                const bool v0 = sel && k0 <= tok && (br == 1 || k0 > tok - 512), v1 = sel && k1 <= tok && (br == 1 || k1 > tok - 512);
                p0[r] = v0 ? p0[r] : NEGB; p1[r] = v1 ? p1[r] : NEGB; tmax = fmaxf(tmax, fmaxf(p0[r], p1[r])); }
            tmax = fmaxf(tmax, __shfl_xor(tmax, 32));
            const float mn = fmaxf(m, tmax), alpha = ex2(m - mn); m = mn;
            float ps = 0.f;
#pragma unroll
            for (int r = 0; r < 16; ++r) { p0[r] = p0[r] > -1e29f ? ex2(p0[r] - mn) : 0.f; p1[r] = p1[r] > -1e29f ? ex2(p1[r] - mn) : 0.f; ps += p0[r] + p1[r]; }
            l = l * alpha + ps;
#pragma unroll
            for (int r = 0; r < 16; ++r) { o[0][r] *= alpha; o[1][r] *= alpha; }
            bf16x8 pf[4]; pf[0] = pack8(p0, 0); pf[1] = pack8(p0, 8); pf[2] = pack8(p1, 0); pf[3] = pack8(p1, 8);
#pragma unroll
            for (int dblk = 0; dblk < 2; ++dblk)
#pragma unroll
                for (int ks = 0; ks < 4; ++ks) {
                    const LAS bf16_t* vp = Vt + (32 * dblk + q) * 72 + 16 * ks + 4 * hi;
                    const s16x4 lo = *(const LAS s16x4*)vp, hh = *(const LAS s16x4*)(vp + 8);
                    const bf16x8 vf = (bf16x8){lo[0], lo[1], lo[2], lo[3], hh[0], hh[1], hh[2], hh[3]};
                    o[dblk] = MFMA32(vf, pf[ks], o[dblk]);
                }
        }
        l += __shfl_xor(l, 32);
        const float gate = ((const float*)(P.ws + WS_G))[row * 24 + head * 3 + (br == 0 ? 2 : 1)];
        const float sc = l > 0.f ? gate / l : 0.f;
#pragma unroll
        for (int r = 0; r < 16; ++r) { ow[0][r] += o[0][r] * sc; ow[1][r] += o[1][r] * sc; }
    }
    const bf16_t* ocp = (const bf16_t*)(P.ws + WS_OC) + row * 512 + head * 64;
    const bf16_t* bgp = (const bf16_t*)(P.ws + WS_BG) + row * 512 + head * 64;
    bf16_t* hp = (bf16_t*)(P.ws + WS_H2) + row * 1024 + 512 + head * 64;
#pragma unroll
    for (int dblk = 0; dblk < 2; ++dblk)
#pragma unroll
        for (int i = 0; i < 4; ++i) { const int d0 = 32 * dblk + 8 * i + 4 * hi;
            const u32x2 oc = *(const u32x2*)(ocp + d0), bg = *(const u32x2*)(bgp + d0);
            u32x2 w; w.x = pk2((ow[dblk][4 * i] + bflo(oc.x)) * bflo(bg.x), (ow[dblk][4 * i + 1] + bfhi(oc.x)) * bfhi(bg.x));
            w.y = pk2((ow[dblk][4 * i + 2] + bflo(oc.y)) * bflo(bg.y), (ow[dblk][4 * i + 3] + bfhi(oc.y)) * bfhi(bg.y));
            *(u32x2*)(hp + d0) = w; }
}

__device__ __forceinline__ void sample_attn_task(const Prm& P, Ctx& C, int task) {
    const int b = task >> 3, kvh = (task >> 2) & 1, ts = task & 3; const size_t row = (size_t)MP + 4 * b + ts;
    LAS float* qs = (LAS float*)C.lds;
    LAS float* part = (LAS float*)(C.lds + 1024);
    LAS float* res = (LAS float*)(C.lds + 1024 + 8 * 4 * 66 * 4);
    LAS int* blist = (LAS int*)(C.lds + 1024 + 8 * 4 * 66 * 4 + 2048);
    const int lane = C.lane, tid = C.tid;
    __syncthreads();
    if (tid < 256) qs[tid] = bf2f(((const bf16_t*)(P.ws + WS_Q))[row * 512 + (4 * kvh + (tid >> 6)) * 64 + (tid & 63)]);
    if (tid == 0) { const unsigned* mk = (const unsigned*)(P.ws + WS_SELMS) + (row - MP) * 16 + kvh * 8; int n = 0;
        for (int w = 0; w < 8; ++w) { unsigned x = mk[w]; while (x && n < 15) { const int bit = __ffs(x) - 1; blist[n++] = 32 * w + bit; x &= x - 1; } }
        while (n < 15) blist[n++] = 0;
        blist[15] = 256; }
    __syncthreads();
#pragma unroll 1
    for (int br = 0; br < 2; ++br) {
        float m[4], l[4], o[4];
#pragma unroll
        for (int gq = 0; gq < 4; ++gq) { m[gq] = NEGB; l[gq] = 0.f; o[gq] = 0.f; }
        const int nseg = br == 0 ? 16 : 9;
#pragma unroll 1
        for (int si = C.wave; si < nseg; si += NWAVES) {
            const float* base; bool valid; int nk = 64;
            if (br == 0) { const int j = blist[si];
                if (j < 256) { const int phys = P.page_table[b * NPAGES + (j >> 1)]; base = P.cache_s + ((size_t)phys * PAGE + (j & 1) * 64) * 256; valid = true; }
                else { base = P.out + O_KSS + (size_t)(b * 4) * 256; valid = lane <= ts; nk = 4; } }
            else { if (si < 8) { base = P.state_win + ((size_t)b * 512 + 64 * si) * 256; valid = (64 * si + lane) >= 1 + ts; }
                else { base = P.out + O_WINS + ((size_t)b * 512 + 508) * 256; valid = lane <= ts; nk = 4; } }
            float s[4] = {0.f, 0.f, 0.f, 0.f};
            if (lane < nk) { const f32x4* kp = (const f32x4*)(base + (size_t)lane * 256 + kvh * 64);
#pragma unroll 4
                for (int c4 = 0; c4 < 16; ++c4) { const f32x4 kv = kp[c4];
#pragma unroll
                    for (int gq = 0; gq < 4; ++gq) { const f32x4 qv = *(const LAS f32x4*)(qs + gq * 64 + 4 * c4); s[gq] += kv[0] * qv[0] + kv[1] * qv[1] + kv[2] * qv[2] + kv[3] * qv[3]; } } }
            valid = valid && lane < nk;
            float p[4];
#pragma unroll
            for (int gq = 0; gq < 4; ++gq) { const float sv = valid ? s[gq] : NEGB; const float mx = wave_max(sv); const float mn = fmaxf(m[gq], mx), a = ex2(m[gq] - mn);
                p[gq] = valid ? ex2(sv - mn) : 0.f; l[gq] = l[gq] * a + p[gq]; o[gq] *= a; m[gq] = mn; }
            const float* vb = base + 128 + kvh * 64 + lane;
#pragma unroll 4
            for (int k = 0; k < nk; ++k) { const float vv = vb[(size_t)k * 256];
#pragma unroll
                for (int gq = 0; gq < 4; ++gq) o[gq] += __uint_as_float(__builtin_amdgcn_readlane(__float_as_uint(p[gq]), k)) * vv; }
        }
#pragma unroll
        for (int gq = 0; gq < 4; ++gq) { const float lt = wave_sum(l[gq]); LAS float* pp = part + (C.wave * 4 + gq) * 66; if (lane == 0) { pp[0] = m[gq]; pp[1] = lt; } pp[2 + lane] = o[gq]; }
        __syncthreads();
        if (tid < 256) { const int gq = tid >> 6, d = tid & 63; float M = NEGB;
            for (int w = 0; w < 8; ++w) M = fmaxf(M, part[(w * 4 + gq) * 66]);
            float L = 0.f, O = 0.f;
            for (int w = 0; w < 8; ++w) { const LAS float* pp = part + (w * 4 + gq) * 66; const float f = ex2(pp[0] - M); L += pp[1] * f; O += pp[2 + d] * f; }
            res[(br * 4 + gq) * 64 + d] = L > 0.f ? O / L : 0.f; }
        __syncthreads();
    }
    if (tid < 256) { const int gq = tid >> 6, d = tid & 63, head = 4 * kvh + gq; const float* G = (const float*)(P.ws + WS_G) + row * 24 + head * 3;
        float v = bf2f(((const bf16_t*)(P.ws + WS_OC))[row * 512 + head * 64 + d]) + G[1] * res[gq * 64 + d] + G[2] * res[(4 + gq) * 64 + d];
        v *= bf2f(((const bf16_t*)(P.ws + WS_BG))[row * 512 + head * 64 + d]);
        ((bf16_t*)(P.ws + WS_H2))[row * 1024 + 512 + head * 64 + d] = (bf16_t)f2bf(v); }
}
__device__ __forceinline__ void phase_attn(const Prm& P, Ctx& C) {
    for (int task = C.bid; task < 256; task += C.G) sample_attn_task(P, C, task);
    __syncthreads();
    for (int i = 0;; ++i) {
        const int u = i * C.G + C.bid; if (u >= 1024) break;
        const int bk = u >> 7; int tb = u & 127; if (i & 1) tb = 127 - tb;
        attn_unit_v1(P, C, bk >> 1, bk & 1, tb);
    }
}

constexpr int NPHASE = 12;
__global__ void __launch_bounds__(NTHR, 2) fwd(Prm P) {
    extern __shared__ __attribute__((aligned(16))) unsigned char lds_raw[];
    Ctx C; C.lds = (LAS unsigned char*)lds_raw; C.tid = threadIdx.x; C.lane = C.tid & 63; C.wave = __builtin_amdgcn_readfirstlane(C.tid >> 6); C.G = gridDim.x; C.bid = blockIdx.x;
    volatile LAS unsigned* MISC = (volatile LAS unsigned*)(C.lds + MISC_OFF);
    if (C.tid < 32) MISC[C.tid] = 0u;
    __syncthreads();
    unsigned char* ws = P.ws;
    unsigned* ctl = (unsigned*)(ws + WS_CTL);
    XcdBarrier bar; bar.bar = ctl + CW_BAR; bar.x = 0; bar.st = nullptr;
    const int lo = P.ph_lo, hi = P.ph_hi;
    if (hi - lo > 1) bar = xcd_barrier_post(ctl + CW_BAR, MISC + 8);
#define IN(k) (lo <= (k) && (k) < hi)
#define SEAM(k) do { if (IN(k) && IN((k) + 1)) xcd_barrier(bar); } while (0)

    if (IN(0)) { phase_prologue(P, C); } SEAM(0);
    if (IN(1)) {
        pg8::Gemm g{(const bf16_t*)(ws + WS_XA), (const bf16_t*)(ws + WS_W1T), 1024, 1024, 1024, 0};
        pg8::StaticOrder S; S.init(MA, N1, C.G, C.bid);
        Epi1 E{(bf16_t*)(ws + WS_U), (bf16_t*)(ws + WS_AG), (bf16_t*)(ws + WS_Q), (bf16_t*)(ws + WS_KS), (bf16_t*)(ws + WS_KW), (bf16_t*)(ws + WS_BG), (float*)(ws + WS_G), P.out};
        pg8::gemm_phase<Epi1, pg8::StaticOrder>(C.lds, g, S, E);
    } SEAM(1);
    if (IN(2)) { phase_conv(P, C); } SEAM(2);
    if (IN(3)) { phase_cmp(P, C); } SEAM(3);
    if (IN(4)) { phase_attn(P, C); } SEAM(4);
    if (IN(5)) {
        pg8::Gemm g{(const bf16_t*)(ws + WS_H2), (const bf16_t*)(ws + WS_W2T), 1024, 1024, 1024, 0};
        pg8::StaticOrder S; S.init(MA, 1024, C.G, C.bid);
        EpiF32 E{(float*)(ws + WS_DP), 1024};
        pg8::gemm_phase<EpiF32, pg8::StaticOrder>(C.lds, g, S, E);
    } SEAM(5);
    if (IN(6)) { phase_ln<0>(P, C); } SEAM(6);
    if (IN(7)) {
        pg8::Gemm g{(const bf16_t*)(ws + WS_X1A), (const bf16_t*)(ws + WS_W3T), 1024, 1024, 1024, 0};
        pg8::StaticOrder S; S.init(MA, 2048, C.G, C.bid);
        Epi3 E{(bf16_t*)(ws + WS_V), (bf16_t*)(ws + WS_GT), P.out};
        pg8::gemm_phase<Epi3, pg8::StaticOrder>(C.lds, g, S, E);
    } SEAM(7);
    if (IN(8)) { phase_pool(P, C); } SEAM(8);
    if (IN(9)) {
        pg8::Gemm g{(const bf16_t*)(ws + WS_DM), (const bf16_t*)(ws + WS_W4T), 1024, 256, 256, 256};
        pg8::StaticOrder S; S.init(MA, 1024, C.G, C.bid);
        Epi4 E{(const bf16_t*)(ws + WS_GT), P.pool_scale, (bf16_t*)(ws + WS_MX)};
        pg8::gemm_phase<Epi4, pg8::StaticOrder>(C.lds, g, S, E);
    } SEAM(9);
    if (IN(10)) {
        pg8::Gemm g{(const bf16_t*)(ws + WS_MX), (const bf16_t*)(ws + WS_W5T), 1024, 1024, 1024, 0};
        pg8::StaticOrder S; S.init(MA, 1024, C.G, C.bid);
        EpiF32 E{(float*)(ws + WS_DP2), 1024};
        pg8::gemm_phase<EpiF32, pg8::StaticOrder>(C.lds, g, S, E);
    } SEAM(10);
    if (IN(11)) { phase_ln<1>(P, C); }
#undef IN
#undef SEAM
}

extern "C" void kernel_launch(void* const* d_in, const int* in_sizes, int n_in, void* d_out, int out_size, void* d_ws, size_t ws_size, hipStream_t stream) {
    static int grid = 0;
    if (grid == 0) {
        if (n_in != 21 || (size_t)out_size != O_TOTAL || ws_size < WS_END) { fprintf(stderr, "kernel_launch: unexpected sizes n_in %d out %d ws %zu\n", n_in, out_size, ws_size); grid = -1; return; }
        int dev = 0, cus = 0, per_cu = 0;
        if (hipGetDevice(&dev) != hipSuccess || hipDeviceGetAttribute(&cus, hipDeviceAttributeMultiprocessorCount, dev) != hipSuccess) { grid = -1; return; }
        if (hipFuncSetAttribute((const void*)fwd, hipFuncAttributeMaxDynamicSharedMemorySize, LDS_BYTES) != hipSuccess) { fprintf(stderr, "kernel_launch: hipFuncSetAttribute failed\n"); grid = -1; return; }
        if (hipOccupancyMaxActiveBlocksPerMultiprocessor(&per_cu, (const void*)fwd, NTHR, LDS_BYTES) != hipSuccess || per_cu < 1) fprintf(stderr, "kernel_launch: occupancy query says %d\n", per_cu);
        (void)hipGetLastError();
        grid = cus;
    }
    if (grid < 0) return;
    (void)hipMemsetAsync((char*)d_ws + WS_CTL, 0, CTL_ZERO_BYTES, stream);
    Prm p{};
    p.x_prompt = (const float*)d_in[0]; p.x_sample = (const float*)d_in[1]; p.cache_c = (const float*)d_in[2]; p.cache_s = (const float*)d_in[3];
    p.state_win = (const float*)d_in[4]; p.state_conv = (const float*)d_in[5]; p.state_pool = (const float*)d_in[6]; p.page_table = (const int*)d_in[7];
    p.w_in_even = (const float*)d_in[8]; p.w_cmp = (const float*)d_in[9]; p.conv_w = (const float*)d_in[10]; p.conv_b = (const float*)d_in[11];
    p.conv_ln_g = (const float*)d_in[12]; p.conv_ln_b = (const float*)d_in[13]; p.w_out_even = (const float*)d_in[14]; p.w_in_odd = (const float*)d_in[15];
    p.w_grp = (const float*)d_in[16]; p.pool_scale = (const float*)d_in[17]; p.w_out_odd = (const float*)d_in[18]; p.ln_g = (const float*)d_in[19]; p.ln_b = (const float*)d_in[20];
    p.out = (float*)d_out; p.ws = (unsigned char*)d_ws;
#if N_LAUNCH_MODE == 1
    p.ph_lo = 0; p.ph_hi = NPHASE;
    hipLaunchKernelGGL(fwd, dim3(grid), dim3(NTHR), LDS_BYTES, stream, p);
#else
    for (int ph = 0; ph < NPHASE; ++ph) { p.ph_lo = ph; p.ph_hi = ph + 1; hipLaunchKernelGGL(fwd, dim3(grid), dim3(NTHR), LDS_BYTES, stream, p); }
#endif
}
```

```cpp
#include <hip/hip_runtime.h>
#include <cstdio>
#include <cstdint>

#ifndef N_LAUNCH_MODE
#define N_LAUNCH_MODE 1
#endif

#define LAS __attribute__((address_space(3)))
#define GAS __attribute__((address_space(1)))
typedef unsigned short bf16_t;
typedef short bf16x8 __attribute__((ext_vector_type(8)));
typedef short s16x4 __attribute__((ext_vector_type(4)));
typedef float f32x4 __attribute__((ext_vector_type(4)));
typedef float f32x2 __attribute__((ext_vector_type(2)));
typedef float f32x16 __attribute__((ext_vector_type(16)));
typedef unsigned u32x4 __attribute__((ext_vector_type(4)));
typedef unsigned u32x2 __attribute__((ext_vector_type(2)));

constexpr int DM = 1024, NBATCH = 4, SEQ = 8192, MP = NBATCH * SEQ, DB = 32, DS = 4, MS = DB * DS, MR = MP + MS, MA = 33024;
constexpr int PAST = 16384, PAGE = 128, NPAGES = PAST / PAGE;
constexpr int WC = 512, WA = 512, KVW = 256, E_IN = 3352, N1 = 3584;
constexpr float LN_EPS = 1e-5f, ALPHA = 1.41421356237309515f;
constexpr float C2 = 0.125f * 1.4426950408889634f;
constexpr float NEGB = -1e30f;
constexpr size_t O_Y = 0, O_YS = 33554432, O_KC = O_YS + 131072, O_KSEL = O_KC + 8388608, O_WIN = O_KSEL + 8388608, O_CONV = O_WIN + 524288,
                 O_POOL = O_CONV + 61440, O_KCS = O_POOL + 61440, O_KSS = O_KCS + 32768, O_WINS = O_KSS + 32768, O_CONVS = O_WINS + 4194304,
                 O_POOLS = O_CONVS + 491520, O_TOTAL = O_POOLS + 491520;
constexpr size_t MiB = 1u << 20;
constexpr size_t WS_CTL = 0, CTL_ZERO_BYTES = 1 * MiB;
constexpr size_t WS_W1T = 2 * MiB, WS_W2T = 9 * MiB, WS_W3T = 11 * MiB, WS_W4T = 15 * MiB, WS_W5T = 16 * MiB, WS_KC = 18 * MiB, WS_SELM = 19 * MiB, WS_SELMS = 20 * MiB,
                 WS_G = 21 * MiB, WS_KCS = 25 * MiB, WS_XA = 48 * MiB, WS_U = 113 * MiB, WS_AG = 146 * MiB, WS_Q = 179 * MiB, WS_BG = 212 * MiB, WS_KS = 245 * MiB,
                 WS_KW = 262 * MiB, WS_OC = 279 * MiB, WS_H2 = 312 * MiB, WS_DP = 377 * MiB, WS_X1 = 507 * MiB, WS_X1A = 636 * MiB, WS_V = 701 * MiB, WS_GT = 766 * MiB,
                 WS_DM = 831 * MiB, WS_MX = 896 * MiB, WS_DP2 = 961 * MiB, WS_END = 1091 * MiB;
constexpr int CW_BAR = 4096;

constexpr int NWAVES = 8, NTHR = 512;
constexpr int LDS_BYTES = 147456, RING_BYTES = 131072, MISC_OFF = RING_BYTES + 320;

struct Prm {
    const float *x_prompt, *x_sample, *cache_c, *cache_s, *state_win, *state_conv, *state_pool;
    const int* page_table;
    const float *w_in_even, *w_cmp, *conv_w, *conv_b, *conv_ln_g, *conv_ln_b, *w_out_even, *w_in_odd, *w_grp, *pool_scale, *w_out_odd, *ln_g, *ln_b;
    float* out; unsigned char* ws;
    int ph_lo, ph_hi;
};

__device__ __forceinline__ unsigned f2bf(float f) { unsigned u = __builtin_bit_cast(unsigned, f); return (u + 0x7fffu + ((u >> 16) & 1u)) >> 16; }
__device__ __forceinline__ unsigned pk2(float lo, float hi) { return f2bf(lo) | (f2bf(hi) << 16); }
__device__ __forceinline__ float bf2f(unsigned short h) { return __builtin_bit_cast(float, (unsigned)h << 16); }
__device__ __forceinline__ float bflo(unsigned w) { return __builtin_bit_cast(float, w << 16); }
__device__ __forceinline__ float bfhi(unsigned w) { return __builtin_bit_cast(float, w & 0xffff0000u); }
__device__ __forceinline__ float sigmoidf_(float x) { return __builtin_amdgcn_rcpf(1.0f + __expf(-x)); }
__device__ __forceinline__ float siluf_(float x) { return x * sigmoidf_(x); }
__device__ __forceinline__ float ex2(float x) { return __builtin_amdgcn_exp2f(x); }
__device__ __forceinline__ float wave_sum(float v) {
#pragma unroll
    for (int o = 1; o < 64; o <<= 1) v += __shfl_xor(v, o);
    return v;
}
__device__ __forceinline__ float wave_max(float v) {
#pragma unroll
    for (int o = 1; o < 64; o <<= 1) v = fmaxf(v, __shfl_xor(v, o));
    return v;
}
__device__ __forceinline__ int crow(int r, int hi) { return (r & 3) + 8 * (r >> 2) + 4 * hi; }
#define LDS_WAIT() asm volatile("s_waitcnt lgkmcnt(0)" ::: "memory")

namespace pg8 {
constexpr int BM = 256, BK = 64, HALF = 128, HTB = HALF * BK * 2, STAGE_BYTES = 8 * HTB, NXCD = 8, WGM = 8;
__host__ __device__ __forceinline__ int lds_byte(int r, int c) { const int st = (r >> 4) * 2 + (c >> 5), rr = r & 15, cc = c & 31, ob = rr * 64 + cc * 2; return st * 1024 + (ob ^ (((ob >> 9) & 1) << 5)); }
__host__ __device__ __forceinline__ void stage_rc(int b, int& R, int& C) { const int st = b / 1024, sb = b % 1024, swz = sb ^ (((sb >> 9) & 1) << 5); R = (st >> 1) * 16 + swz / 64; C = (st & 1) * 32 + (swz % 64) / 2; }
__host__ __device__ __forceinline__ int perm32(int rho) { const int n = rho >> 4, i = rho & 15; return 8 * (i >> 2) + 4 * n + (i & 3); }
struct Unit { int pm, pn; };
struct Gemm { const bf16_t* A; const bf16_t* Bt; int lda, ldb, K, a_pn_off; };
struct StaticOrder {
    int nM, nN, nwg, G, c;
    __host__ __device__ void init(int M, int N, int G_, int c_) { nM = M / BM; nN = N / BM; nwg = nM * nN; G = G_; c = c_; }
    __host__ __device__ bool next(int i, Unit& u) const {
        const long L = (long)i * G + c; if (L >= nwg) return false;
        int wgid = (int)L; { const int q = nwg / NXCD, r = nwg % NXCD, xcd = wgid % NXCD, off = wgid / NXCD; wgid = (xcd < r ? xcd * (q + 1) : r * (q + 1) + (xcd - r) * q) + off; }
        const int nig = WGM * nN, gid = wgid / nig, fm = gid * WGM, gsz = (nM - fm) < WGM ? (nM - fm) : WGM;
        u.pm = fm + ((wgid % nig) % gsz); u.pn = (wgid % nig) / gsz; return true;
    }
};
template <class Epi, class Sched, bool ALIGN_EPI = true>
__device__ __forceinline__ void gemm_phase(LAS unsigned char* lds, const Gemm g, const Sched& S, const Epi& E, const int tid) {
    const int wid = __builtin_amdgcn_readfirstlane(tid >> 6), lane = tid & 63, wr = wid >> 2, wc = wid & 3, fr = lane & 15, fq = lane >> 4;
    const int K = g.K, nt = K / BK;
    unsigned voffA[2], voffB[2];
#pragma unroll
    for (int i = 0; i < 2; ++i) { int R, C; stage_rc(tid * 16 + i * 8192, R, C); const int Rb = Epi::PERM ? ((R & ~31) + perm32(R & 31)) : R;
        voffA[i] = (unsigned)(R * g.lda + C) * 2u; voffB[i] = (unsigned)(Rb * g.ldb + C) * 2u; }
    const size_t kstep = (size_t)(BK * 2);
    const size_t hstepA = (size_t)HALF * g.lda * 2, hstepB = (size_t)HALF * g.ldb * 2;
    const size_t tstepA = 2 * hstepA, tstepB = 2 * hstepB;
    const unsigned ldsw = (unsigned)wid * 1024u;
    const int aoff = lds_byte(wr * 64 + fr, fq * 8), boff = lds_byte(wc * 32 + fr, fq * 8);
#define PG8_SA(b, h) (((b) * 2 + (h)) * HTB)
#define PG8_SB(b, h) ((4 + (b) * 2 + (h)) * HTB)
#define PG8_STAGE(bufoff, gbase, voff) do { _Pragma("unroll") for (int _i = 0; _i < 2; ++_i) \
        __builtin_amdgcn_global_load_lds((const unsigned*)((const char*)(gbase) + (voff)[_i]), (LAS unsigned*)(lds + (bufoff) + ldsw + _i * 8192), 16, 0, 0); } while (0)
#define PG8_LDA(dst, b, h) do { _Pragma("unroll") for (int m = 0; m < 4; ++m) _Pragma("unroll") for (int k = 0; k < 2; ++k) dst[m][k] = *(const LAS bf16x8*)(lds + PG8_SA(b, h) + aoff + m * 2048 + k * 1024); } while (0)
#define PG8_LDB(dst, b, h) do { _Pragma("unroll") for (int n = 0; n < 2; ++n) _Pragma("unroll") for (int k = 0; k < 2; ++k) dst[n][k] = *(const LAS bf16x8*)(lds + PG8_SB(b, h) + boff + n * 2048 + k * 1024); } while (0)
#define PG8_MMA(ai, bj, At, Bt) do { __builtin_amdgcn_s_setprio(1); _Pragma("unroll") for (int m = 0; m < 4; ++m) _Pragma("unroll") for (int n = 0; n < 2; ++n) _Pragma("unroll") for (int k = 0; k < 2; ++k) \
        acc[ai][bj][m][n] = __builtin_amdgcn_mfma_f32_16x16x32_bf16(Bt[n][k], At[m][k], acc[ai][bj][m][n], 0, 0, 0); __builtin_amdgcn_s_setprio(0); } while (0)
#define PG8_WAIT_V(n) asm volatile("s_waitcnt vmcnt(" #n ")" ::: "memory")
#define PG8_WAIT_L(n) asm volatile("s_waitcnt lgkmcnt(" #n ")" ::: "memory")
#define PG8_BAR __builtin_amdgcn_s_barrier()
#define PG8_SCHED __builtin_amdgcn_sched_barrier(0)
    Unit cur, nxt; int ui = 0;
    if (!S.next(0, cur)) return;
    f32x4 acc[2][2][4][2];
#pragma unroll
    for (int a = 0; a < 2; ++a)
#pragma unroll
        for (int b = 0; b < 2; ++b)
#pragma unroll
            for (int m = 0; m < 4; ++m)
#pragma unroll
                for (int n = 0; n < 2; ++n) acc[a][b][m][n] = (f32x4){0.f, 0.f, 0.f, 0.f};
    bf16x8 At[4][2], B0[2][2], B1[2][2];
    const char* cA = (const char*)g.A + (size_t)cur.pm * tstepA + (size_t)cur.pn * g.a_pn_off * 2; const char* cB = (const char*)g.Bt + (size_t)cur.pn * tstepB;
    {
        PG8_STAGE(PG8_SB(0, 0), cB, voffB); PG8_STAGE(PG8_SB(0, 1), cB + hstepB, voffB); PG8_STAGE(PG8_SA(0, 0), cA, voffA); PG8_STAGE(PG8_SA(0, 1), cA + hstepA, voffA);
        if (wr == 1) PG8_BAR;
        PG8_WAIT_V(2); PG8_BAR;
        PG8_STAGE(PG8_SB(1, 0), cB + kstep, voffB); PG8_STAGE(PG8_SA(1, 0), cA + kstep, voffA); PG8_STAGE(PG8_SB(1, 1), cB + hstepB + kstep, voffB);
        PG8_WAIT_V(6); PG8_BAR;
    }
    for (;;) {
        const bool has_next = S.next(ui + 1, nxt);
        const char* nA = has_next ? (const char*)g.A + (size_t)nxt.pm * tstepA + (size_t)nxt.pn * g.a_pn_off * 2 : cA; const char* nB = has_next ? (const char*)g.Bt + (size_t)nxt.pn * tstepB : cB;
        for (int t = 0; t < nt; t += 2) {
            const bool last = (t == nt - 2);
            const char* a1 = cA + (size_t)(t + 1) * kstep;
            const char* a2 = last ? nA : cA + (size_t)(t + 2) * kstep; const char* b2 = last ? nB : cB + (size_t)(t + 2) * kstep;
            const char* a3 = a2 + kstep; const char* b3 = b2 + kstep;
            PG8_LDB(B0, 0, 0); PG8_LDB(B1, 0, 1); PG8_SCHED; PG8_LDA(At, 0, 0); PG8_STAGE(PG8_SA(1, 1), a1 + hstepA, voffA);
            PG8_WAIT_V(8); PG8_WAIT_L(0); PG8_BAR; PG8_MMA(0, 0, At, B0); PG8_MMA(0, 1, At, B1); PG8_BAR; PG8_SCHED;
            PG8_LDA(At, 0, 1); PG8_STAGE(PG8_SB(0, 0), b2, voffB); PG8_STAGE(PG8_SB(0, 1), b2 + hstepB, voffB); PG8_STAGE(PG8_SA(0, 0), a2, voffA);
            PG8_WAIT_V(8); PG8_WAIT_L(0); PG8_BAR; PG8_MMA(1, 0, At, B0); PG8_MMA(1, 1, At, B1); PG8_BAR; PG8_SCHED;
            PG8_LDB(B0, 1, 0); PG8_LDB(B1, 1, 1); PG8_SCHED; PG8_LDA(At, 1, 0); PG8_STAGE(PG8_SA(0, 1), a2 + hstepA, voffA);
            PG8_WAIT_V(8); PG8_WAIT_L(0); PG8_BAR; PG8_MMA(0, 0, At, B0); PG8_MMA(0, 1, At, B1); PG8_BAR; PG8_SCHED;
            PG8_LDA(At, 1, 1); PG8_STAGE(PG8_SB(1, 0), b3, voffB); PG8_STAGE(PG8_SB(1, 1), b3 + hstepB, voffB); PG8_STAGE(PG8_SA(1, 0), a3, voffA);
            PG8_WAIT_V(8); PG8_WAIT_L(0); PG8_BAR; PG8_MMA(1, 0, At, B0); PG8_MMA(1, 1, At, B1); PG8_BAR; PG8_SCHED;
        }
        if constexpr (ALIGN_EPI) { if (wr == 0) PG8_BAR; }
        E(acc, cur, wr, wc, fr, fq);
        if (!has_next) break;
#pragma unroll
        for (int a = 0; a < 2; ++a)
#pragma unroll
            for (int b = 0; b < 2; ++b)
#pragma unroll
                for (int m = 0; m < 4; ++m)
#pragma unroll
                    for (int n = 0; n < 2; ++n) acc[a][b][m][n] = (f32x4){0.f, 0.f, 0.f, 0.f};
        cur = nxt; cA = nA; cB = nB; ++ui;
        if constexpr (ALIGN_EPI) { if (wr == 1) PG8_BAR; }
    }
    PG8_WAIT_V(0);
    if constexpr (!ALIGN_EPI) { if (wr == 0) PG8_BAR; }
    PG8_BAR;
#undef PG8_SA
#undef PG8_SB
#undef PG8_STAGE
#undef PG8_LDA
#undef PG8_LDB
#undef PG8_MMA
#undef PG8_WAIT_V
#undef PG8_WAIT_L
#undef PG8_BAR
#undef PG8_SCHED
}
}

__device__ __forceinline__ void st8bf(bf16_t* p, f32x4 a, f32x4 b) { u32x4 w; w.x = pk2(a[0], a[1]); w.y = pk2(a[2], a[3]); w.z = pk2(b[0], b[1]); w.w = pk2(b[2], b[3]); *(u32x4*)p = w; }
__device__ __forceinline__ f32x4 sig4(f32x4 v) { f32x4 r; r[0] = sigmoidf_(v[0]); r[1] = sigmoidf_(v[1]); r[2] = sigmoidf_(v[2]); r[3] = sigmoidf_(v[3]); return r; }

struct Epi1 {
    static constexpr bool PERM = true;
    bf16_t *U, *AG, *Q, *KS, *KW, *BG; float* G; float* out;
    __device__ __forceinline__ void operator()(const f32x4 (&acc)[2][2][4][2], const pg8::Unit& u, int wr, int wc, int fr, int fq) const {
        const int pn = u.pn, cw = wc * 32 + 8 * fq;
#pragma unroll
        for (int ai = 0; ai < 2; ++ai)
#pragma unroll
            for (int m = 0; m < 4; ++m) {
                const int row = u.pm * 256 + ai * 128 + wr * 64 + m * 16 + fr;
                if (row >= MR) continue;
                const bool smp = row >= MP;
                const int b = smp ? (row - MP) >> 2 : row >> 13, t = smp ? (row - MP) & 3 : row & (SEQ - 1);
                if (pn < 4) {
                    f32x4 v0 = acc[ai][0][m][0] * sig4(acc[ai][1][m][0]), v1 = acc[ai][0][m][1] * sig4(acc[ai][1][m][1]);
                    const int col = pn * 128 + cw;
                    st8bf(U + (size_t)row * 512 + col, v0, v1);
                    float* o = nullptr;
                    if (!smp) { if (t >= SEQ - 30) o = out + O_CONV + ((size_t)b * 30 + (t - (SEQ - 30))) * 512 + col; }
                    else o = out + O_CONVS + ((size_t)b * 30 + 26 + t) * 512 + col;
                    if (o) { *(f32x4*)o = v0; *(f32x4*)(o + 4) = v1; }
                } else if (pn < 6 || pn == 11 || pn == 12) {
                    bf16_t* dst = (pn < 6 ? AG : BG) + (size_t)row * 512 + (pn < 6 ? pn - 4 : pn - 11) * 256 + cw;
#pragma unroll
                    for (int bj = 0; bj < 2; ++bj) { const f32x4 a = acc[ai][bj][m][0], c = acc[ai][bj][m][1]; st8bf(dst + bj * 128, a * sig4(a), c * sig4(c)); }
                } else if (pn < 8) {
                    bf16_t* dst = Q + (size_t)row * 512 + (pn - 6) * 256 + cw;
#pragma unroll
                    for (int bj = 0; bj < 2; ++bj) st8bf(dst + bj * 128, acc[ai][bj][m][0] * C2, acc[ai][bj][m][1] * C2);
                } else if (pn == 8) {
                    float* o = (smp ? out + O_KCS + (size_t)(row - MP) * 256 : out + O_KC + (size_t)row * 256) + cw;
#pragma unroll
                    for (int bj = 0; bj < 2; ++bj) { *(f32x4*)(o + bj * 128) = acc[ai][bj][m][0]; *(f32x4*)(o + bj * 128 + 4) = acc[ai][bj][m][1]; }
                } else if (pn == 9) {
                    float* o = (smp ? out + O_KSS + (size_t)(row - MP) * 256 : out + O_KSEL + (size_t)row * 256) + cw;
                    bf16_t* dst = KS + (size_t)row * 256 + cw;
#pragma unroll
                    for (int bj = 0; bj < 2; ++bj) { *(f32x4*)(o + bj * 128) = acc[ai][bj][m][0]; *(f32x4*)(o + bj * 128 + 4) = acc[ai][bj][m][1]; st8bf(dst + bj * 128, acc[ai][bj][m][0], acc[ai][bj][m][1]); }
                } else if (pn == 10) {
                    float* o = nullptr;
                    if (!smp) { if (t >= SEQ - 512) o = out + O_WIN + ((size_t)b * 512 + (t - (SEQ - 512))) * 256 + cw; }
                    else o = out + O_WINS + ((size_t)b * 512 + 508 + t) * 256 + cw;
                    bf16_t* dst = KW + (size_t)row * 256 + cw;
#pragma unroll
                    for (int bj = 0; bj < 2; ++bj) { st8bf(dst + bj * 128, acc[ai][bj][m][0], acc[ai][bj][m][1]);
                        if (o) { *(f32x4*)(o + bj * 128) = acc[ai][bj][m][0]; *(f32x4*)(o + bj * 128 + 4) = acc[ai][bj][m][1]; } }
                } else {
                    if (wc == 0 && fq < 3) { float* o = G + (size_t)row * 24 + 8 * fq; *(f32x4*)o = sig4(acc[ai][0][m][0]); *(f32x4*)(o + 4) = sig4(acc[ai][0][m][1]); }
                }
            }
    }
};
struct EpiF32 {
    static constexpr bool PERM = false;
    float* O; int ldc;
    __device__ __forceinline__ void operator()(const f32x4 (&acc)[2][2][4][2], const pg8::Unit& u, int wr, int wc, int fr, int fq) const {
#pragma unroll
        for (int ai = 0; ai < 2; ++ai)
#pragma unroll
            for (int m = 0; m < 4; ++m) {
                const int row = u.pm * 256 + ai * 128 + wr * 64 + m * 16 + fr;
                if (row >= MR) continue;
                float* o = O + (size_t)row * ldc + u.pn * 256 + wc * 32 + 4 * fq;
#pragma unroll
                for (int bj = 0; bj < 2; ++bj)
#pragma unroll
                    for (int n = 0; n < 2; ++n) *(f32x4*)(o + bj * 128 + n * 16) = acc[ai][bj][m][n];
            }
    }
};
struct Epi3 {
    static constexpr bool PERM = true;
    bf16_t *V, *GT; float* out;
    __device__ __forceinline__ void operator()(const f32x4 (&acc)[2][2][4][2], const pg8::Unit& u, int wr, int wc, int fr, int fq) const {
        const int pn = u.pn, cw = wc * 32 + 8 * fq;
#pragma unroll
        for (int ai = 0; ai < 2; ++ai)
#pragma unroll
            for (int m = 0; m < 4; ++m) {
                const int row = u.pm * 256 + ai * 128 + wr * 64 + m * 16 + fr;
                if (row >= MR) continue;
                const bool smp = row >= MP;
                const int b = smp ? (row - MP) >> 2 : row >> 13, t = smp ? (row - MP) & 3 : row & (SEQ - 1);
                if (pn < 4) {
                    const int col = pn * 256 + cw;
                    float* o = nullptr;
                    if (!smp) { if (t >= SEQ - 15) o = out + O_POOL + ((size_t)b * 15 + (t - (SEQ - 15))) * 1024 + col; }
                    else o = out + O_POOLS + ((size_t)b * 15 + 11 + t) * 1024 + col;
#pragma unroll
                    for (int bj = 0; bj < 2; ++bj) { st8bf(V + (size_t)row * 1024 + col + bj * 128, acc[ai][bj][m][0], acc[ai][bj][m][1]);
                        if (o) { *(f32x4*)(o + bj * 128) = acc[ai][bj][m][0]; *(f32x4*)(o + bj * 128 + 4) = acc[ai][bj][m][1]; } }
                } else {
                    bf16_t* dst = GT + (size_t)row * 1024 + (pn - 4) * 256 + cw;
#pragma unroll
                    for (int bj = 0; bj < 2; ++bj) { const f32x4 a = acc[ai][bj][m][0], c = acc[ai][bj][m][1]; st8bf(dst + bj * 128, a * sig4(a), c * sig4(c)); }
                }
            }
    }
};
struct Epi4 {
    static constexpr bool PERM = true;
    const bf16_t* GT; const float* scale; bf16_t* MX;
    __device__ __forceinline__ void operator()(const f32x4 (&acc)[2][2][4][2], const pg8::Unit& u, int wr, int wc, int fr, int fq) const {
        const int cw = u.pn * 256 + wc * 32 + 8 * fq;
#pragma unroll
        for (int ai = 0; ai < 2; ++ai)
#pragma unroll
            for (int m = 0; m < 4; ++m) {
                const int row = u.pm * 256 + ai * 128 + wr * 64 + m * 16 + fr;
                if (row >= MR) continue;
#pragma unroll
                for (int bj = 0; bj < 2; ++bj) {
                    const int col = cw + bj * 128;
                    const u32x4 gw = *(const u32x4*)(GT + (size_t)row * 1024 + col);
                    const f32x4 s0 = *(const f32x4*)(scale + col), s1 = *(const f32x4*)(scale + col + 4);
                    f32x4 a = acc[ai][bj][m][0] * s0, c = acc[ai][bj][m][1] * s1;
                    a[0] *= bflo(gw.x); a[1] *= bfhi(gw.x); a[2] *= bflo(gw.y); a[3] *= bfhi(gw.y);
                    c[0] *= bflo(gw.z); c[1] *= bfhi(gw.z); c[2] *= bflo(gw.w); c[3] *= bfhi(gw.w);
                    st8bf(MX + (size_t)row * 1024 + col, a, c);
                }
            }
    }
};
#define XB_TMO      128
#define XB_XCNT(j)  (256  + 64 * (j))
#define XB_XSUB(j)  (1280 + 64 * (j))
#define XB_XGEN(j)  (2304 + 64 * (j))
#define XB_TOP      3328
#define XB_TOPGEN   3392
#define XCD_BAR_WORDS 3456
#define XB_SPIN_CAP (1u << 18)

__device__ __forceinline__ unsigned xb_ld(unsigned* p)              { return __hip_atomic_load(p, __ATOMIC_RELAXED, __HIP_MEMORY_SCOPE_AGENT); }
__device__ __forceinline__ unsigned xb_add(unsigned* p, unsigned v) { return __hip_atomic_fetch_add(p, v, __ATOMIC_RELAXED, __HIP_MEMORY_SCOPE_AGENT); }
__device__ __forceinline__ unsigned xb_xcc_id() { return (unsigned)__builtin_amdgcn_s_getreg((3 << 11) | 20) & 0xFu; }
#define XB_SPIN(cond, bar) do { unsigned _sp = 0; while (cond) { __builtin_amdgcn_s_sleep(1); \
    if ((++_sp & 255u) == 0u) { if (xb_ld(&(bar)[XB_TMO])) break; if (_sp > XB_SPIN_CAP) { atomicAdd(&(bar)[XB_TMO], 1u); break; } } } } while (0)

struct XcdBarrier {
    unsigned* bar; unsigned x;
    volatile LAS unsigned* st;
};

__device__ __forceinline__ XcdBarrier xcd_barrier_post(unsigned* bar, volatile LAS unsigned* st) {
    XcdBarrier b; b.bar = bar; b.x = xb_xcc_id(); b.st = st;
    if (threadIdx.x == 0) (void)xb_add(&bar[XB_XCNT(b.x)], 1u);
    return b;
}
__device__ __forceinline__ void xcd_barrier_complete(unsigned* bar, unsigned x, unsigned& nloc, unsigned& nx) {
    const unsigned G = gridDim.x * gridDim.y * gridDim.z;
    unsigned sum, cnt, mine, sp = 0u;
    for (;;) {
        sum = 0u; cnt = 0u; mine = 0u;
#pragma unroll
        for (unsigned j = 0; j < 16; ++j) { const unsigned c = xb_ld(&bar[XB_XCNT(j)]); sum += c; cnt += (c > 0u) ? 1u : 0u; mine = (j == x) ? c : mine; }
        if (sum == G) break;
        __builtin_amdgcn_s_sleep(1);
        if ((++sp & 255u) == 0u) { if (xb_ld(&bar[XB_TMO])) break; if (sp > XB_SPIN_CAP) { atomicAdd(&bar[XB_TMO], 1u); break; } }
    }
    nloc = mine > 0u ? mine : 1u; nx = cnt > 0u ? cnt : 1u;
}

__device__ __forceinline__ void xcd_barrier(const XcdBarrier& b) {
    asm volatile("s_waitcnt vmcnt(0)" ::: "memory");
    __syncthreads();
    if (threadIdx.x == 0) {
        unsigned* bar = b.bar;
        __builtin_amdgcn_s_waitcnt(0);
        unsigned nloc = b.st[0], nx = b.st[1];
        if (nloc == 0u) { xcd_barrier_complete(bar, b.x, nloc, nx); b.st[0] = nloc; b.st[1] = nx; }
        const unsigned old = xb_add(&bar[XB_XSUB(b.x)], 1u);
        const unsigned gen = old / nloc;
        if (old + 1u == (gen + 1u) * nloc) {
            __builtin_amdgcn_fence(__ATOMIC_RELEASE, "agent");
            asm volatile("s_waitcnt vmcnt(0)" ::: "memory");
            const unsigned og = xb_add(&bar[XB_TOP], 1u);
            const unsigned tg = og / nx;
            if (og + 1u == (tg + 1u) * nx) xb_add(&bar[XB_TOPGEN], 1u);
            else XB_SPIN(xb_ld(&bar[XB_TOPGEN]) == tg, bar);
            __builtin_amdgcn_fence(__ATOMIC_ACQUIRE, "agent");
            xb_add(&bar[XB_XGEN(b.x)], 1u);
            asm volatile("s_waitcnt vmcnt(0)" ::: "memory");
        } else {
            XB_SPIN(xb_ld(&bar[XB_XGEN(b.x)]) == gen, bar);
            __builtin_amdgcn_fence(__ATOMIC_ACQUIRE, "agent");
            asm volatile("s_waitcnt vmcnt(0)" ::: "memory");
        }
    }
    __syncthreads();
}

struct Ctx { LAS unsigned char* lds; int tid, lane, wave, G, bid; };

__device__ __forceinline__ int w1_src_col(int blk) {
    const int p = blk >> 3, r = (blk & 7) * 32;
    if (p < 4) return r < 128 ? 128 * p + r : 512 + 128 * p + (r - 128);
    if (p < 6) return 1024 + 256 * (p - 4) + r;
    if (p < 8) return 1536 + 256 * (p - 6) + r;
    if (p == 8) return 2048 + r;
    if (p == 9) return 2304 + r;
    if (p == 10) return 2560 + r;
    if (p < 13) return 2840 + 256 * (p - 11) + r;
    return r == 0 ? 2816 : -1;
}
__device__ __forceinline__ void p0_transpose_item(const float* W, int Nsrc, bf16_t* WT, int Kdst, int k0, int src_col0, int dst_row0, LAS float* scr, int lane) {
#pragma unroll 8
    for (int i = 0; i < 32; ++i) { const int kk = 2 * i + (lane >> 5); scr[kk * 33 + (lane & 31)] = (src_col0 >= 0) ? W[(size_t)(k0 + kk) * Nsrc + src_col0 + (lane & 31)] : 0.f; }
    LDS_WAIT();
    const int c = lane & 7;
#pragma unroll
    for (int j = 0; j < 4; ++j) { const int n = (lane >> 3) + 8 * j; const LAS float* s = scr + (8 * c) * 33 + n;
        u32x4 o; o.x = pk2(s[0 * 33], s[1 * 33]); o.y = pk2(s[2 * 33], s[3 * 33]); o.z = pk2(s[4 * 33], s[5 * 33]); o.w = pk2(s[6 * 33], s[7 * 33]);
        *(u32x4*)(WT + (size_t)(dst_row0 + n) * Kdst + k0 + 8 * c) = o; }
    LDS_WAIT();
}
template <class RowPtr>
__device__ __forceinline__ void compress_task(const RowPtr& rp, int nrows, int p, const LAS float* wl, bf16_t* dst, int nmax, int lane) {
    f32x4 Aprev = (f32x4){0.f, 0.f, 0.f, 0.f};
    for (int i = 0; i <= 8; ++i) {
        const int r0 = 128 * p + 16 * i;
        if (r0 >= nrows) break;
        f32x4 v[16];
#pragma unroll
        for (int j = 0; j < 16; ++j) v[j] = __builtin_nontemporal_load((const f32x4*)(rp(r0 + j)) + lane);
        f32x4 A = (f32x4){0.f, 0.f, 0.f, 0.f}, B = A;
#pragma unroll
        for (int j = 0; j < 16; ++j) { const f32x4 wa = *(const LAS f32x4*)(wl + j * 256 + 4 * lane), wb = *(const LAS f32x4*)(wl + (16 + j) * 256 + 4 * lane); A += v[j] * wa; B += v[j] * wb; }
        if (i >= 1) { const int n = 8 * p + i - 1; if (n < nmax) { const f32x4 s = Aprev + B; u32x2 o; o.x = pk2(s[0], s[1]); o.y = pk2(s[2], s[3]); *(u32x2*)(dst + (size_t)n * 256 + 4 * lane) = o; } }
        Aprev = A;
    }
}
struct RowsPaged { const float* cache; const int* pt; __device__ __forceinline__ const float* operator()(int r) const { return cache + ((size_t)pt[r >> 7] * PAGE + (r & (PAGE - 1))) * 256; } };
struct RowsFlat { const float* base; __device__ __forceinline__ const float* operator()(int r) const { return base + (size_t)r * 256; } };

__device__ __forceinline__ void load_wcmp(const Prm& P, Ctx& C, LAS float* wl) { for (int i = C.tid; i < 32 * 256 / 4; i += NTHR) ((LAS f32x4*)wl)[i] = ((const f32x4*)P.w_cmp)[i]; }

__device__ __forceinline__ void phase_prologue(const Prm& P, Ctx& C) {
    unsigned char* ws = P.ws;
    const int gw = C.bid * NWAVES + C.wave, NGW = C.G * NWAVES;
    LAS float* wl = (LAS float*)(C.lds + 73728);
    load_wcmp(P, C, wl);
    __syncthreads();
    bf16_t* KCS = (bf16_t*)(ws + WS_KCS);
    for (int tk = gw; tk < DB * NPAGES; tk += NGW) {
        const int b = tk >> 7, p = tk & 127;
        RowsPaged rp{P.cache_c, P.page_table + b * NPAGES};
        compress_task(rp, PAST, p, wl, KCS + (size_t)b * 1024 * 256, 1023, C.lane);
        if (p == 127) *(u32x2*)(KCS + ((size_t)b * 1024 + 1023) * 256 + 4 * C.lane) = (u32x2){0u, 0u};
    }
    LAS float* scr = (LAS float*)(C.lds + C.wave * 8704);
    for (int it = gw; it < 3968; it += NGW) {
        int r = it;
        if (r < 1792) { const int blk = r >> 4, kb = r & 15; p0_transpose_item(P.w_in_even, E_IN, (bf16_t*)(ws + WS_W1T), 1024, 64 * kb, w1_src_col(blk), 32 * blk, scr, C.lane); continue; } r -= 1792;
        if (r < 512) { const int blk = r >> 4, kb = r & 15; p0_transpose_item(P.w_out_even, 1024, (bf16_t*)(ws + WS_W2T), 1024, 64 * kb, 32 * blk, 32 * blk, scr, C.lane); continue; } r -= 512;
        if (r < 1024) { const int blk = r >> 4, kb = r & 15; p0_transpose_item(P.w_in_odd, 2048, (bf16_t*)(ws + WS_W3T), 1024, 64 * kb, 32 * blk, 32 * blk, scr, C.lane); continue; } r -= 1024;
        if (r < 128) { const int g = r >> 5, rr = r & 31, blk = rr >> 2, kb = rr & 3; p0_transpose_item(P.w_grp + g * 65536, 256, (bf16_t*)(ws + WS_W4T) + g * 65536, 256, 64 * kb, 32 * blk, 32 * blk, scr, C.lane); continue; } r -= 128;
        { const int blk = r >> 4, kb = r & 15; p0_transpose_item(P.w_out_odd, 1024, (bf16_t*)(ws + WS_W5T), 1024, 64 * kb, 32 * blk, 32 * blk, scr, C.lane); }
    }
    bf16_t* XA = (bf16_t*)(ws + WS_XA);
    for (int m = gw; m < MA; m += NGW) {
        const float* src = m < MP ? P.x_prompt + (size_t)m * DM : (m < MR ? P.x_sample + (size_t)(m - MP) * DM : nullptr);
#pragma unroll
        for (int j = 0; j < 4; ++j) { f32x4 v = src ? *(const f32x4*)(src + 4 * C.lane + 256 * j) : (f32x4){0.f, 0.f, 0.f, 0.f};
            u32x2 o; o.x = pk2(v[0], v[1]); o.y = pk2(v[2], v[3]); *(u32x2*)(XA + (size_t)m * DM + 4 * C.lane + 256 * j) = o; }
    }
    const int gt = C.bid * NTHR + C.tid, NGT = C.G * NTHR;
    for (int i = gt; i < DB * 508 * 64; i += NGT) { const int b = i / (508 * 64), r = i % (508 * 64); ((f32x4*)(P.out + O_WINS + (size_t)b * 512 * 256))[r] = ((const f32x4*)(P.state_win + ((size_t)b * 512 + 4) * 256))[r]; }
    for (int i = gt; i < DB * 26 * 128; i += NGT) { const int b = i / (26 * 128), r = i % (26 * 128); ((f32x4*)(P.out + O_CONVS + (size_t)b * 30 * 512))[r] = ((const f32x4*)(P.state_conv + ((size_t)b * 30 + 4) * 512))[r]; }
    for (int i = gt; i < DB * 11 * 256; i += NGT) { const int b = i / (11 * 256), r = i % (11 * 256); ((f32x4*)(P.out + O_POOLS + (size_t)b * 15 * 1024))[r] = ((const f32x4*)(P.state_pool + ((size_t)b * 15 + 4) * 1024))[r]; }
    for (int i = gt; i < (MA - MR) * 1024 / 8; i += NGT) ((u32x4*)(ws + WS_H2 + (size_t)MR * 1024 * 2))[i] = (u32x4){0u, 0u, 0u, 0u};
}

template <int NT, bool SMP>
__device__ __forceinline__ void conv_body(const Prm& P, Ctx& C, int b, int t0) {
    const int c = C.tid;
    const bf16_t* U = (const bf16_t*)(P.ws + WS_U);
    const int row0 = SMP ? MP + 4 * b : b * SEQ + t0;
    float uu[30 + NT];
#pragma unroll
    for (int i = 0; i < 30 + NT; ++i) {
        if (SMP) uu[i] = i < 30 ? P.state_conv[((size_t)b * 30 + i) * 512 + c] : bf2f(U[(size_t)(row0 + i - 30) * 512 + c]);
        else { const int ti = t0 - 30 + i; uu[i] = ti >= 0 ? bf2f(U[(size_t)(row0 + i - 30) * 512 + c]) : 0.f; }
    }
    float w[31];
#pragma unroll
    for (int k = 0; k < 31; ++k) w[k] = P.conv_w[k * 512 + c];
    const float bias = P.conv_b[c];
    LAS float* y = (LAS float*)C.lds;
#pragma unroll
    for (int i = 0; i < NT; ++i) { float a = bias;
#pragma unroll
        for (int k = 0; k < 31; ++k) a += w[k] * uu[i + k];
        y[i * 512 + c] = a; }
    __syncthreads();
    const bf16_t* AG = (const bf16_t*)(P.ws + WS_AG); bf16_t* H2 = (bf16_t*)(P.ws + WS_H2);
    for (int i = C.wave; i < NT; i += NWAVES) {
        float v[8], s = 0.f;
#pragma unroll
        for (int j = 0; j < 8; ++j) { v[j] = y[i * 512 + C.lane + 64 * j]; s += v[j]; }
        const float mean = wave_sum(s) * (1.f / 512.f); float q = 0.f;
#pragma unroll
        for (int j = 0; j < 8; ++j) { v[j] -= mean; q += v[j] * v[j]; }
        const float rstd = 1.f / sqrtf(wave_sum(q) * (1.f / 512.f) + LN_EPS);
        const size_t row = (size_t)(row0 + i);
#pragma unroll
        for (int j = 0; j < 8; ++j) { const int cc = C.lane + 64 * j; float z = v[j] * rstd * P.conv_ln_g[cc] + P.conv_ln_b[cc]; z = siluf_(z) * bf2f(AG[row * 512 + cc]); H2[row * 1024 + cc] = (bf16_t)f2bf(z); }
    }
    __syncthreads();
}
__device__ __forceinline__ void phase_conv(const Prm& P, Ctx& C) {
    LAS float* wl = (LAS float*)(C.lds + 73728);
    load_wcmp(P, C, wl);
    __syncthreads();
    for (int un = C.bid; un < 1024 + DB; un += C.G) {
        if (un < 1024) conv_body<32, false>(P, C, un >> 8, (un & 255) * 32);
        else conv_body<4, true>(P, C, un - 1024, 0);
    }
    const int gw = C.bid * NWAVES + C.wave, NGW = C.G * NWAVES;
    bf16_t* KC = (bf16_t*)(P.ws + WS_KC);
    for (int tk = gw; tk < NBATCH * 64; tk += NGW) {
        const int b = tk >> 6, p = tk & 63;
        RowsFlat rp{P.out + O_KC + (size_t)b * SEQ * 256};
        compress_task(rp, SEQ, p, wl, KC + (size_t)b * 512 * 256, 511, C.lane);
        if (p == 63) *(u32x2*)(KC + ((size_t)b * 512 + 511) * 256 + 4 * C.lane) = (u32x2){0u, 0u};
    }
}

template <int LAYER>
__device__ __forceinline__ void phase_ln(const Prm& P, Ctx& C) {
    const int gw = C.bid * NWAVES + C.wave, NGW = C.G * NWAVES;
    const float* dp = (const float*)(P.ws + (LAYER == 0 ? WS_DP : WS_DP2));
    const float* gam = P.ln_g + LAYER * DM; const float* bet = P.ln_b + LAYER * DM;
    for (int m = gw; m < MR; m += NGW) {
        const float* xin = LAYER == 0 ? (m < MP ? P.x_prompt + (size_t)m * DM : P.x_sample + (size_t)(m - MP) * DM) : (const float*)(P.ws + WS_X1) + (size_t)m * DM;
        float* of = LAYER == 0 ? (float*)(P.ws + WS_X1) + (size_t)m * DM : (m < MP ? P.out + O_Y + (size_t)m * DM : P.out + O_YS + (size_t)(m - MP) * DM);
        f32x4 v[4]; float s = 0.f;
#pragma unroll
        for (int j = 0; j < 4; ++j) { const f32x4 a = *(const f32x4*)(xin + 4 * C.lane + 256 * j), d = *(const f32x4*)(dp + (size_t)m * DM + 4 * C.lane + 256 * j); v[j] = a * ALPHA + d; s += (v[j][0] + v[j][1]) + (v[j][2] + v[j][3]); }
        const float mean = wave_sum(s) * (1.f / DM); float q = 0.f;
#pragma unroll
        for (int j = 0; j < 4; ++j) { v[j] = v[j] - mean; q += (v[j][0] * v[j][0] + v[j][1] * v[j][1]) + (v[j][2] * v[j][2] + v[j][3] * v[j][3]); }
        const float rstd = 1.f / sqrtf(wave_sum(q) * (1.f / DM) + LN_EPS);
#pragma unroll
        for (int j = 0; j < 4; ++j) { const f32x4 gg = *(const f32x4*)(gam + 4 * C.lane + 256 * j), bb = *(const f32x4*)(bet + 4 * C.lane + 256 * j); const f32x4 o = v[j] * rstd * gg + bb;
            *(f32x4*)(of + 4 * C.lane + 256 * j) = o;
            if (LAYER == 0) { u32x2 w; w.x = pk2(o[0], o[1]); w.y = pk2(o[2], o[3]); *(u32x2*)((bf16_t*)(P.ws + WS_X1A) + (size_t)m * DM + 4 * C.lane + 256 * j) = w; } }
    }
}

__device__ __forceinline__ void phase_pool(const Prm& P, Ctx& C) {
    const bf16_t* V = (const bf16_t*)(P.ws + WS_V); bf16_t* D = (bf16_t*)(P.ws + WS_DM);
    const int gt = C.bid * NTHR + C.tid, NGT = C.G * NTHR;
    for (int i = gt; i < MR * 128; i += NGT) {
        const int row = i >> 7, c0 = (i & 127) * 8, w = 2 << (c0 >> 8);
        float s[8];
#pragma unroll
        for (int e = 0; e < 8; ++e) s[e] = 0.f;
        float cnt;
        if (row < MP) {
            const int t = row & (SEQ - 1); const int nk = t + 1 < w ? t + 1 : w; cnt = (float)nk;
            for (int k = 0; k < nk; ++k) { const u32x4 x = *(const u32x4*)(V + (size_t)(row - k) * 1024 + c0);
                s[0] += bflo(x.x); s[1] += bfhi(x.x); s[2] += bflo(x.y); s[3] += bfhi(x.y); s[4] += bflo(x.z); s[5] += bfhi(x.z); s[6] += bflo(x.w); s[7] += bfhi(x.w); }
        } else {
            const int b = (row - MP) >> 2, ts = (row - MP) & 3; cnt = (float)w;
            for (int k = 0; k < w; ++k) { const int e = 15 + ts - k;
                if (e >= 15) { const u32x4 x = *(const u32x4*)(V + (size_t)(MP + 4 * b + e - 15) * 1024 + c0);
                    s[0] += bflo(x.x); s[1] += bfhi(x.x); s[2] += bflo(x.y); s[3] += bfhi(x.y); s[4] += bflo(x.z); s[5] += bfhi(x.z); s[6] += bflo(x.w); s[7] += bfhi(x.w); }
                else { const float* sp = P.state_pool + ((size_t)b * 15 + e) * 1024 + c0; const f32x4 a = *(const f32x4*)sp, d = *(const f32x4*)(sp + 4);
                    s[0] += a[0]; s[1] += a[1]; s[2] += a[2]; s[3] += a[3]; s[4] += d[0]; s[5] += d[1]; s[6] += d[2]; s[7] += d[3]; } }
        }
        const u32x4 x = *(const u32x4*)(V + (size_t)row * 1024 + c0); const float inv = 1.f / cnt;
        u32x4 o; o.x = pk2(s[0] * inv - bflo(x.x), s[1] * inv - bfhi(x.x)); o.y = pk2(s[2] * inv - bflo(x.y), s[3] * inv - bfhi(x.y));
        o.z = pk2(s[4] * inv - bflo(x.z), s[5] * inv - bfhi(x.z)); o.w = pk2(s[6] * inv - bflo(x.w), s[7] * inv - bfhi(x.w));
        *(u32x4*)(D + (size_t)row * 1024 + c0) = o;
    }
}

#define MFMA32(a, b, c) __builtin_amdgcn_mfma_f32_32x32x16_bf16((a), (b), (c), 0, 0, 0)
__device__ __forceinline__ bf16x8 pack8(const f32x16& p, int base) {
    u32x4 w; w.x = pk2(p[base + 0], p[base + 1]); w.y = pk2(p[base + 2], p[base + 3]); w.z = pk2(p[base + 4], p[base + 5]); w.w = pk2(p[base + 6], p[base + 7]);
    return __builtin_bit_cast(bf16x8, w);
}

template <int NBL>
__device__ __forceinline__ unsigned topk_select(const LAS float* sc  , int sub, int cur) {
    unsigned v[NBL]; unsigned candm = 0u, forced = 0u;
#pragma unroll
    for (int e = 0; e < NBL; ++e) { const int j = sub * NBL + e; const bool cand = (j >= 1) && (j <= cur - 2);
        v[e] = cand ? __float_as_uint(sc[j]) : 0u; if (cand) candm |= 1u << e;
        if (j == 0 || j == cur || (j == cur - 1 && cur >= 1)) forced |= 1u << e; }
    const int nf = cur == 0 ? 1 : (cur == 1 ? 2 : 3), kk = 16 - nf, ncand = cur - 2 > 0 ? cur - 2 : 0;
    unsigned prefix = 0u;
    for (int bit = 30; bit >= 0; --bit) {
        const unsigned trial = prefix | (1u << bit); int cnt = 0;
#pragma unroll
        for (int e = 0; e < NBL; ++e) cnt += (v[e] >= trial) ? 1 : 0;
        cnt += __shfl_xor(cnt, 1); cnt += __shfl_xor(cnt, 2); cnt += __shfl_xor(cnt, 4);
        if (cnt >= kk) prefix = trial;
    }
    unsigned gt = 0u, eq = 0u;
#pragma unroll
    for (int e = 0; e < NBL; ++e) { if ((candm >> e) & 1u) { if (v[e] > prefix) gt |= 1u << e; else if (v[e] == prefix) eq |= 1u << e; } }
    int ngt = __popc(gt); ngt += __shfl_xor(ngt, 1); ngt += __shfl_xor(ngt, 2); ngt += __shfl_xor(ngt, 4);
    const int eqc = __popc(eq); int inc = eqc;
    { int t1 = __shfl_up(inc, 1, 8); if (sub >= 1) inc += t1; t1 = __shfl_up(inc, 2, 8); if (sub >= 2) inc += t1; t1 = __shfl_up(inc, 4, 8); if (sub >= 4) inc += t1; }
    int take = (kk - ngt) - (inc - eqc); take = take < 0 ? 0 : (take > eqc ? eqc : take);
    unsigned seleq = 0u, tmp = eq;
    for (int i = 0; i < take; ++i) { const unsigned low = tmp & (0u - tmp); seleq |= low; tmp ^= low; }
    const unsigned sel = (ncand <= kk) ? candm : (gt | seleq);
    return sel | forced;
}

template <bool SMP>
__device__ __forceinline__ void cmp_wave_task(const Prm& P, int task, LAS float* sc, int lane) {
    constexpr int NBLK = SMP ? 256 : 128, NBL = NBLK / 8;
    const int q = lane & 31, hi = lane >> 5, slot = q >> 2, g = q & 3;
    int b, kvh, tg = 0;
    if (SMP) { b = task >> 1; kvh = task & 1; } else { const int bk = task >> 10; tg = task & 1023; b = bk >> 1; kvh = bk & 1; }
    const int tok = SMP ? (slot < 3 ? slot : 3) : 8 * tg + slot;
    const size_t row = SMP ? (size_t)(MP + 4 * b + tok) : (size_t)b * SEQ + tok;
    const int head = 4 * kvh + g;
    const int nvq = SMP ? 1023 : (tok >= 31 ? ((tok - 31) >> 4) + 1 : 0);
    const int tlast = 8 * tg + 7;
    const int nvmax = SMP ? 1023 : (tlast >= 31 ? ((tlast - 31) >> 4) + 1 : 0);
    const int ntile = (nvmax + 31) >> 5;
    const bf16_t* Kb = SMP ? (const bf16_t*)(P.ws + WS_KCS) + (size_t)b * 1024 * 256 + kvh * 64 : (const bf16_t*)(P.ws + WS_KC) + (size_t)b * 512 * 256 + kvh * 64;
    const bf16_t* Vb = Kb + 128;
    const bf16_t* Qp = (const bf16_t*)(P.ws + WS_Q) + row * 512 + head * 64 + 8 * hi;
    bf16x8 qf[4];
#pragma unroll
    for (int s = 0; s < 4; ++s) qf[s] = *(const bf16x8*)(Qp + 16 * s);
    float m = NEGB, l = 0.f;
    for (int tile = 0; tile < ntile; ++tile) {
        const bf16_t* kp = Kb + (size_t)(32 * tile + q) * 256 + 8 * hi;
        f32x16 S = {};
#pragma unroll
        for (int s = 0; s < 4; ++s) S = MFMA32(*(const bf16x8*)(kp + 16 * s), qf[s], S);
        float tmax = NEGB;
#pragma unroll
        for (int r = 0; r < 16; ++r) { const bool valid = (32 * tile + crow(r, hi)) < nvq; S[r] = valid ? S[r] : NEGB; tmax = fmaxf(tmax, S[r]); }
        const float mn = fmaxf(m, tmax); float ps = 0.f;
#pragma unroll
        for (int r = 0; r < 16; ++r) ps += (S[r] > -1e29f) ? ex2(S[r] - mn) : 0.f;
        l = l * ex2(m - mn) + ps; m = mn;
    }
    { const float mo = __shfl_xor(m, 32), lo = __shfl_xor(l, 32); const float M = fmaxf(m, mo); l = l * ex2(m - M) + lo * ex2(mo - M); m = M; }
    const float invl = l > 0.f ? 1.f / l : 0.f;
    for (int i = lane; i < 8 * NBLK; i += 64) sc[i] = 0.f;
    LDS_WAIT();
    f32x16 o[2]; o[0] = f32x16{}; o[1] = f32x16{};
    for (int tile = 0; tile < ntile; ++tile) {
        const bf16_t* kp = Kb + (size_t)(32 * tile + q) * 256 + 8 * hi;
        f32x16 S = {};
#pragma unroll
        for (int s = 0; s < 4; ++s) S = MFMA32(*(const bf16x8*)(kp + 16 * s), qf[s], S);
#pragma unroll
        for (int r = 0; r < 16; ++r) { const bool valid = (32 * tile + crow(r, hi)) < nvq; S[r] = valid ? ex2(S[r] - m) * invl : 0.f; }
#pragma unroll
        for (int i = 0; i < 4; ++i) { float v = S[4 * i] + S[4 * i + 1] + S[4 * i + 2]; v += __shfl_xor(v, 1); v += __shfl_xor(v, 2); if (g == 0) sc[slot * NBLK + 8 * tile + 2 * i + hi] = v; }
        bf16x8 pf[2]; pf[0] = pack8(S, 0); pf[1] = pack8(S, 8);
#pragma unroll
        for (int dblk = 0; dblk < 2; ++dblk)
#pragma unroll
            for (int ks = 0; ks < 2; ++ks) {
                bf16x8 vf;
#pragma unroll
                for (int e = 0; e < 8; ++e) vf[e] = (short)Vb[(size_t)(32 * tile + 16 * ks + 8 * (e >> 2) + 4 * hi + (e & 3)) * 256 + 32 * dblk + q];
                o[dblk] = MFMA32(vf, pf[ks], o[dblk]);
            }
    }
    if (!SMP || slot < 4) {
        const float gate = ((const float*)(P.ws + WS_G))[row * 24 + head * 3 + 0];
        bf16_t* op = (bf16_t*)(P.ws + WS_OC) + row * 512 + head * 64;
#pragma unroll
        for (int dblk = 0; dblk < 2; ++dblk)
#pragma unroll
            for (int i = 0; i < 4; ++i) { u32x2 w; w.x = pk2(o[dblk][4 * i] * gate, o[dblk][4 * i + 1] * gate); w.y = pk2(o[dblk][4 * i + 2] * gate, o[dblk][4 * i + 3] * gate);
                *(u32x2*)(op + 32 * dblk + 8 * i + 4 * hi) = w; }
    }
    LDS_WAIT();
    {
        const int slot2 = lane >> 3, sub = lane & 7;
        const int tok2 = SMP ? (slot2 < 3 ? slot2 : 3) : 8 * tg + slot2;
        const int cur = SMP ? 256 : tok2 >> 6;
        unsigned bits = topk_select<NBL>(sc + slot2 * NBLK, sub, cur);
        if (SMP) { if (slot2 < 4) ((unsigned*)(P.ws + WS_SELMS))[((size_t)(4 * b + slot2) * 2 + kvh) * 8 + sub] = bits; }
        else { bits = (sub & 1) ? bits << 16 : bits; bits |= __shfl_xor(bits, 1);
            if (!(sub & 1)) ((unsigned*)(P.ws + WS_SELM))[(((size_t)b * SEQ + tok2) * 2 + kvh) * 4 + (sub >> 1)] = bits; }
    }
    LDS_WAIT();
}
__device__ __forceinline__ void phase_cmp(const Prm& P, Ctx& C) {
    LAS float* sc = (LAS float*)(C.lds + C.wave * 8192);
    const int gw = C.bid * NWAVES + C.wave, NGW = C.G * NWAVES;
    int it = 0;
    for (int task = gw; task < 8192; task += NGW, ++it) {
        const int tg = task & 1023; const int t2 = (task & ~1023) | ((it & 1) ? 1023 - tg : tg);
        cmp_wave_task<false>(P, t2, sc, C.lane);
    }
    if (gw < 64) cmp_wave_task<true>(P, gw, sc, C.lane);
}

__device__ __forceinline__ void sample_attn_task(const Prm& P, Ctx& C, int task) {
    const int b = task >> 3, kvh = (task >> 2) & 1, ts = task & 3; const size_t row = (size_t)MP + 4 * b + ts;
    LAS float* qs = (LAS float*)C.lds;
    LAS float* part = (LAS float*)(C.lds + 1024);
    LAS float* res = (LAS float*)(C.lds + 1024 + 8 * 4 * 66 * 4);
    LAS int* blist = (LAS int*)(C.lds + 1024 + 8 * 4 * 66 * 4 + 2048);
    const int lane = C.lane, tid = C.tid;
    __syncthreads();
    if (tid < 256) qs[tid] = bf2f(((const bf16_t*)(P.ws + WS_Q))[row * 512 + (4 * kvh + (tid >> 6)) * 64 + (tid & 63)]);
    if (tid == 0) { const unsigned* mk = (const unsigned*)(P.ws + WS_SELMS) + (row - MP) * 16 + kvh * 8; int n = 0;
        for (int w = 0; w < 8; ++w) { unsigned x = mk[w]; while (x && n < 15) { const int bit = __ffs(x) - 1; blist[n++] = 32 * w + bit; x &= x - 1; } }
        while (n < 15) blist[n++] = 0;
        blist[15] = 256; }
    __syncthreads();
#pragma unroll 1
    for (int br = 0; br < 2; ++br) {
        float m[4], l[4], o[4];
#pragma unroll
        for (int gq = 0; gq < 4; ++gq) { m[gq] = NEGB; l[gq] = 0.f; o[gq] = 0.f; }
        const int nseg = br == 0 ? 16 : 9;
#pragma unroll 1
        for (int si = C.wave; si < nseg; si += NWAVES) {
            const float* base; bool valid; int nk = 64;
            if (br == 0) { const int j = blist[si];
                if (j < 256) { const int phys = P.page_table[b * NPAGES + (j >> 1)]; base = P.cache_s + ((size_t)phys * PAGE + (j & 1) * 64) * 256; valid = true; }
                else { base = P.out + O_KSS + (size_t)(b * 4) * 256; valid = lane <= ts; nk = 4; } }
            else { if (si < 8) { base = P.state_win + ((size_t)b * 512 + 64 * si) * 256; valid = (64 * si + lane) >= 1 + ts; }
                else { base = P.out + O_WINS + ((size_t)b * 512 + 508) * 256; valid = lane <= ts; nk = 4; } }
            float s[4] = {0.f, 0.f, 0.f, 0.f};
            if (lane < nk) { const f32x4* kp = (const f32x4*)(base + (size_t)lane * 256 + kvh * 64);
#pragma unroll 4
                for (int c4 = 0; c4 < 16; ++c4) { const f32x4 kv = kp[c4];
#pragma unroll
                    for (int gq = 0; gq < 4; ++gq) { const f32x4 qv = *(const LAS f32x4*)(qs + gq * 64 + 4 * c4); s[gq] += kv[0] * qv[0] + kv[1] * qv[1] + kv[2] * qv[2] + kv[3] * qv[3]; } } }
            valid = valid && lane < nk;
            float p[4];
#pragma unroll
            for (int gq = 0; gq < 4; ++gq) { const float sv = valid ? s[gq] : NEGB; const float mx = wave_max(sv); const float mn = fmaxf(m[gq], mx), a = ex2(m[gq] - mn);
                p[gq] = valid ? ex2(sv - mn) : 0.f; l[gq] = l[gq] * a + p[gq]; o[gq] *= a; m[gq] = mn; }
            const float* vb = base + 128 + kvh * 64 + lane;
#pragma unroll 4
            for (int k = 0; k < nk; ++k) { const float vv = vb[(size_t)k * 256];
#pragma unroll
                for (int gq = 0; gq < 4; ++gq) o[gq] += __uint_as_float(__builtin_amdgcn_readlane(__float_as_uint(p[gq]), k)) * vv; }
        }
#pragma unroll
        for (int gq = 0; gq < 4; ++gq) { const float lt = wave_sum(l[gq]); LAS float* pp = part + (C.wave * 4 + gq) * 66; if (lane == 0) { pp[0] = m[gq]; pp[1] = lt; } pp[2 + lane] = o[gq]; }
        __syncthreads();
        if (tid < 256) { const int gq = tid >> 6, d = tid & 63; float M = NEGB;
            for (int w = 0; w < 8; ++w) M = fmaxf(M, part[(w * 4 + gq) * 66]);
            float L = 0.f, O = 0.f;
            for (int w = 0; w < 8; ++w) { const LAS float* pp = part + (w * 4 + gq) * 66; const float f = ex2(pp[0] - M); L += pp[1] * f; O += pp[2 + d] * f; }
            res[(br * 4 + gq) * 64 + d] = L > 0.f ? O / L : 0.f; }
        __syncthreads();
    }
    if (tid < 256) { const int gq = tid >> 6, d = tid & 63, head = 4 * kvh + gq; const float* G = (const float*)(P.ws + WS_G) + row * 24 + head * 3;
        float v = bf2f(((const bf16_t*)(P.ws + WS_OC))[row * 512 + head * 64 + d]) + G[1] * res[gq * 64 + d] + G[2] * res[(4 + gq) * 64 + d];
        v *= bf2f(((const bf16_t*)(P.ws + WS_BG))[row * 512 + head * 64 + d]);
        ((bf16_t*)(P.ws + WS_H2))[row * 1024 + 512 + head * 64 + d] = (bf16_t)f2bf(v); }
}

namespace at2 {
constexpr int QBLK = 32, QB = 256, KVBLK = 64, KP = 256, QP = 512;
constexpr int NSLOT = 3, SLOTB = 8192;
constexpr int WSB = 768;
constexpr int LDS_K = 0, LDS_V = NSLOT * SLOTB, LDS_WS = 2 * NSLOT * SLOTB, LDS_OST = LDS_WS + 8 * WSB, LDS_OS2 = LDS_OST + 8 * 4096, LDS_END = LDS_OS2 + 8 * 4096;
static_assert(LDS_END <= RING_BYTES, "attention LDS");
typedef LAS const char* lds_cptr;
typedef short v4i16_t __attribute__((ext_vector_type(4)));
typedef float f32x2_t __attribute__((ext_vector_type(2))); typedef __bf16 bf16x2_t __attribute__((ext_vector_type(2)));
#define SBAR() __builtin_amdgcn_sched_barrier(0)
#define WAIT_BAR(N) asm volatile("s_waitcnt vmcnt(" #N ") lgkmcnt(0)\n\ts_barrier":::"memory")
__device__ __forceinline__ void glds16(const void* sbase  , unsigned voff, unsigned lds_dst) { unsigned keep;
  asm volatile("s_mov_b32 %0, m0\n\ts_mov_b32 m0, %3\n\ts_nop 0\n\tglobal_load_lds_dwordx4 %1, %2\n\ts_mov_b32 m0, %0" : "=&s"(keep) : "v"(voff), "s"(sbase), "s"(lds_dst) : "memory"); }
__device__ __forceinline__ float max3f(float a, float b, float c) { float r; asm("v_max3_f32 %0, %1, %2, %3" : "=v"(r) : "v"(a), "v"(b), "v"(c)); return r; }
__device__ __forceinline__ float max2f(float a, float b) { float r; asm("v_max_f32_e32 %0, %1, %2" : "=v"(r) : "v"(a), "v"(b)); return r; }
__device__ __forceinline__ float fadd_s(float a, float b) { float r; asm("v_add_f32_e32 %0, %1, %2" : "=v"(r) : "v"(a), "v"(b)); return r; }
__device__ __forceinline__ float fsub_s(float a, float b) { float r; asm("v_sub_f32_e32 %0, %1, %2" : "=v"(r) : "v"(a), "v"(b)); return r; }
__device__ __forceinline__ unsigned cvtpk_s(float lo, float hi) { f32x2_t v = {lo, hi}; bf16x2_t b = __builtin_convertvector(v, bf16x2_t); return __builtin_bit_cast(unsigned, b); }
__device__ __forceinline__ void cmask(f32x16& p0, f32x16& p1, int jb, int qrel, int hi, float NEG) {
  asm volatile("" : "+v"(qrel));
  const int kb = 64 * jb + 4 * hi;
#pragma unroll
  for (int r = 0; r < 16; ++r) { const int kv = kb + (r & 3) + 8 * (r >> 2); if (kv > qrel) p0[r] = NEG; if (kv + 32 > qrel) p1[r] = NEG; }
}
__device__ __forceinline__ void lmask(f32x16& p0, f32x16& p1, int t, int qrel, int hi, float NEG) {
  asm volatile("" : "+v"(qrel));
  const int kb = 64 * t + 4 * hi;
#pragma unroll
  for (int r = 0; r < 16; ++r) { const int kv = kb + (r & 3) + 8 * (r >> 2); if (kv <= qrel) p0[r] = NEG; if (kv + 32 <= qrel) p1[r] = NEG; }
}
__device__ __forceinline__ void kload8(bf16x8* kf, lds_cptr kp) {
  kf[0] = *(const LAS bf16x8*)(kp);        kf[1] = *(const LAS bf16x8*)(kp + 512);
  kf[2] = *(const LAS bf16x8*)(kp + 2048); kf[3] = *(const LAS bf16x8*)(kp + 2560);
  kf[4] = *(const LAS bf16x8*)(kp + 4096); kf[5] = *(const LAS bf16x8*)(kp + 4608);
  kf[6] = *(const LAS bf16x8*)(kp + 6144); kf[7] = *(const LAS bf16x8*)(kp + 6656);
}
__device__ __forceinline__ void kload2(bf16x8* kf, lds_cptr kp, int j) { kf[2 * j] = *(const LAS bf16x8*)(kp + j * 2048); kf[2 * j + 1] = *(const LAS bf16x8*)(kp + j * 2048 + 512); }
__device__ __forceinline__ s16x4 vtr(lds_cptr p) { return __builtin_bit_cast(s16x4, __builtin_amdgcn_ds_read_tr16_b64_v4i16((LAS v4i16_t*)p)); }
__device__ __forceinline__ float rowmax(const f32x16& p0, const f32x16& p1) {
  float a = max3f(p0[0], p0[1], p1[0]), b = max3f(p0[2], p0[3], p1[1]); a = max3f(a, p1[2], p1[3]);
#pragma unroll
  for (int r = 4; r < 16; r += 4) { a = max3f(a, p0[r], p0[r + 1]); b = max3f(b, p0[r + 2], p0[r + 3]); a = max3f(a, p1[r], p1[r + 1]); b = max3f(b, p1[r + 2], p1[r + 3]); }
  const float m = max2f(a, b);
  auto rr = __builtin_amdgcn_permlane32_swap(__float_as_uint(m), __float_as_uint(m), false, false);
  return max2f(__uint_as_float(rr[0]), __uint_as_float(rr[1]));
}
__device__ __forceinline__ void pv(f32x16* o, int vb, bf16x8 pa0, bf16x8 pa1, bf16x8 pa2, bf16x8 pa3) {
#pragma unroll
  for (int d0 = 0; d0 < 2; ++d0) { s16x4 lo[4], hi[4];
#pragma unroll
    for (int ks = 0; ks < 4; ++ks) {
      asm volatile("ds_read_b64_tr_b16 %0,%1 offset:%c2" : "=&v"(lo[ks]) : "v"(vb), "i"(d0 * 4096 + ks * 1024) : "memory");
      asm volatile("ds_read_b64_tr_b16 %0,%1 offset:%c2" : "=&v"(hi[ks]) : "v"(vb), "i"(d0 * 4096 + ks * 1024 + 512) : "memory"); }
    asm volatile("s_waitcnt lgkmcnt(0)" ::: "memory"); SBAR();
#define PK(k) (bf16x8){lo[k][0], lo[k][1], lo[k][2], lo[k][3], hi[k][0], hi[k][1], hi[k][2], hi[k][3]}
    o[d0] = MFMA32(pa0, PK(0), o[d0]); o[d0] = MFMA32(pa1, PK(1), o[d0]); o[d0] = MFMA32(pa2, PK(2), o[d0]); o[d0] = MFMA32(pa3, PK(3), o[d0]);
#undef PK
  }
}

template <int MODE, int THRL>
__device__ __forceinline__ void attn_unit(const Prm& P, int b, int h, int qb, LAS char* shm, int wid) {
  int lane; asm volatile("v_mbcnt_lo_u32_b32 %0, -1, 0\n\tv_mbcnt_hi_u32_b32 %0, -1, %0" : "=v"(lane));
  const int r32 = lane & 31, hi = lane >> 5;
  const int kvh = h >> 2;
  const long rowbase = (long)b * SEQ; const int q0 = qb * QB;
  const int NT = MODE == 0 ? 4 * qb + 4 : (qb >= 2 ? 12 : 4 * qb + 4);
  const int t_lo = 4 * qb + 4 - NT;
  const bool lowband = (MODE == 1) && (NT == 12);
  const float NEG = MODE == 0 ? -INFINITY : -1024.f;
  const bf16_t* Qw = (const bf16_t*)(P.ws + WS_Q) + (rowbase + q0 + wid * QBLK) * QP + h * 64;
  const bf16_t* Kh = (const bf16_t*)(P.ws + (MODE == 0 ? WS_KS : WS_KW)) + (rowbase + (long)t_lo * KVBLK) * KP + kvh * 64;
  const bf16_t* Vh = Kh + 128;
  const unsigned lds0 = (unsigned)(uintptr_t)shm;
  LAS float* wsf = (LAS float*)(shm + LDS_WS + wid * WSB);
  LAS unsigned* selp = (LAS unsigned*)(shm + LDS_WS + wid * WSB + 256) + r32;
  const unsigned ksoff = (unsigned)(lane * KP + wid * 8) * 2u;
  const unsigned vsoff = (unsigned)((16 * (wid & 3) + (lane >> 2)) * KP + (wid >> 2) * 32 + (lane & 3) * 8) * 2u;
  const unsigned kdst = lds0 + LDS_K + wid * 1024, vdst = lds0 + LDS_V + wid * 1024;
#define DMA_K(t, slot) glds16(Kh + (long)(t) * KVBLK * KP, ksoff, (unsigned)__builtin_amdgcn_readfirstlane(kdst + (slot)))
#define DMA_V(t, slot) glds16(Vh + (long)(t) * KVBLK * KP, vsoff, (unsigned)__builtin_amdgcn_readfirstlane(vdst + (slot)))
  const int vb0 = (int)(lds0 + LDS_V) + ((lane >> 4) & 1) * 32 + (lane & 3) * 8 + (4 * hi + ((lane & 15) >> 2)) * 64;
  bf16x8 kf[8];
  const lds_cptr shm3 = (lds_cptr)shm; const lds_cptr kp0 = shm3 + LDS_K + hi * 1024 + r32 * 16; const lds_cptr vp0 = shm3 + LDS_V + ((lane >> 4) & 1) * 32 + (lane & 3) * 8 + (4 * hi + ((lane & 15) >> 2)) * 64;
  DMA_K(0, 0); DMA_V(0, 0); DMA_K(1, SLOTB);
  bf16x8 qr[4];
#pragma unroll
  for (int d0 = 0; d0 < 4; ++d0) qr[d0] = *(const bf16x8*)(&Qw[(long)r32 * QP + d0 * 16 + hi * 8]);
  if (MODE == 0 && hi == 0) { const u32x4 selm = *(const u32x4*)((const unsigned*)(P.ws + WS_SELM) + ((rowbase + q0 + wid * QBLK + r32) * 2 + kvh) * 4);
    selp[0] = selm.x; selp[32] = selm.y; selp[64] = selm.z; selp[96] = selm.w; }
  float mhat = 0.f, l_reg = 0.f; f32x16 o[2]; o[0] = f32x16{}; o[1] = f32x16{}; f32x16 negm = f32x16{}; asm volatile("" : "+v"(negm));
  const int qrel = wid * QBLK + r32;
#define CMASK(P0, P1, t) do { int jb_ = (t) - (NT - 4); if (jb_ >= 0) cmask(P0, P1, jb_, qrel, hi, NEG); if (lowband && (t) < 4) lmask(P0, P1, (t), qrel, hi, NEG); } while (0)
#define NEGSET(t) do { if (MODE == 0) { const int t_ = (t); const unsigned w_ = selp[(t_ >> 5) * 32]; \
    const float cv_ = ((w_ >> (t_ & 31)) & 1u) ? -mhat : -INFINITY; _Pragma("unroll") for (int r = 0; r < 16; ++r) negm[r] = cv_; asm volatile("" : "+v"(negm)); } } while (0)
  bool resc = false;
#define START(P0, P1) do { const float rm = rowmax(P0, P1); resc = false; \
    { const float dl = rm; mhat = fadd_s(mhat, dl); \
      _Pragma("unroll") for (int r = 0; r < 16; ++r) { P0[r] = fsub_s(P0[r], dl); P1[r] = fsub_s(P1[r], dl); } \
      _Pragma("unroll") for (int r = 0; r < 16; ++r) negm[r] = -mhat; asm volatile("" : "+v"(negm)); } \
    _Pragma("unroll") for (int r = 0; r < 16; ++r) P0[r] = __builtin_amdgcn_exp2f(P0[r]); } while (0)
#define RESC() do { if (resc) { asm volatile("s_waitcnt lgkmcnt(0)" ::: "memory"); \
      _Pragma("unroll") for (int d_ = 0; d_ < 2; ++d_) _Pragma("unroll") for (int r = 0; r < 16; ++r) o[d_][r] *= wsf[crow(r, hi)]; } } while (0)
  f32x16 pA0, pA1, pB0, pB1;
  int sl_prev = 0, sl_cur = 0, sl_next = SLOTB;
#define ROT() do { sl_prev = sl_cur; sl_cur = sl_next; sl_next = (sl_next == (NSLOT - 1) * SLOTB) ? 0 : sl_next + SLOTB; } while (0)
  DMA_K(2, 2 * SLOTB);
  WAIT_BAR(3);
  {
    const lds_cptr kb = shm3 + LDS_K + hi * 1024 + r32 * 16;
#pragma unroll
    for (int d0 = 0; d0 < 4; ++d0) {
      const bf16x8 b0 = *(const LAS bf16x8*)(kb + d0 * 2048), b1 = *(const LAS bf16x8*)(kb + d0 * 2048 + 512);
      if (d0 == 0) { pA0 = MFMA32(b0, qr[0], negm); pA1 = MFMA32(b1, qr[0], negm); }
      else { pA0 = MFMA32(b0, qr[d0], pA0); pA1 = MFMA32(b1, qr[d0], pA1); } }
  }
  asm volatile("s_nop 15\n\ts_nop 7" : "+v"(pA0), "+v"(pA1)); CMASK(pA0, pA1, 0);
  START(pA0, pA1);
#pragma unroll
  for (int r = 0; r < 16; ++r) pA1[r] = __builtin_amdgcn_exp2f(pA1[r]);
  WAIT_BAR(0);
  DMA_K(3, 0); DMA_V(1, SLOTB);
  ROT();
  kload8(kf, kp0 + sl_cur);
  WAIT_BAR(2);
  s16x4 vlo[8], vhi[8]; u32x4 pw0, pw1, pw2, pw3;
#define PKW(P, B) cvtpk_s(P[B], P[B + 1])
#define PAF(k) __builtin_bit_cast(bf16x8, pw##k)
#define VFR(i) (bf16x8){vlo[i][0], vlo[i][1], vlo[i][2], vlo[i][3], vhi[i][0], vhi[i][1], vhi[i][2], vhi[i][3]}
#define PIN(x) asm volatile("" : "+v"(x))
#define MX3(a, b, c) __builtin_fmaxf(__builtin_fmaxf((a), (b)), (c))
#define GAPA(MF, A0, A1, A2, A3, W0, W1, PW) do { MF; sacc += A0; sacc += A1; sacc += A2; sacc += A3; PIN(sacc); W0; W1; PIN(PW); SBAR(); } while (0)
#define EX(v) __builtin_amdgcn_exp2f(v)
#define GAPB(MF, X, B) do { MF; X[B] = EX(X[B]); X[B + 1] = EX(X[B + 1]); X[B + 2] = EX(X[B + 2]); X[B + 3] = EX(X[B + 3]); PIN(X); SBAR(); } while (0)
#define VRD(i) do { vlo[i] = vtr(vp_ + (((i) >> 2) * 4096 + ((i) & 3) * 1024)); vhi[i] = vtr(vp_ + (((i) >> 2) * 4096 + ((i) & 3) * 1024 + 512)); } while (0)
#define KRD(G, j) do { if (G) { kload2(kf, kp0 + sl_next, j); SBAR(); } } while (0)
#define STEP(C0, C1, P0, P1, t, GK, GV, GL) do { SBAR(); \
    NEGSET(t); \
    const lds_cptr vp_ = vp0 + sl_prev; \
    VRD(0); SBAR(); float sacc = (P0[0] + P0[1]); \
    GAPA(C0 = MFMA32(kf[0], qr[0], negm), P0[2], P0[3], P0[4], P0[5],     pw0[0] = PKW(P0, 0), pw0[1] = PKW(P0, 2), pw0); \
    VRD(4); SBAR(); GAPA(C1 = MFMA32(kf[1], qr[0], negm), P0[6], P0[7], P0[8], P0[9],     pw0[2] = PKW(P0, 4), pw0[3] = PKW(P0, 6), pw0); \
    VRD(1); SBAR(); GAPA(C0 = MFMA32(kf[2], qr[1], C0),   P0[10], P0[11], P0[12], P0[13], pw1[0] = PKW(P0, 8), pw1[1] = PKW(P0, 10), pw1); \
    VRD(5); SBAR(); GAPA(C1 = MFMA32(kf[3], qr[1], C1),   P0[14], P0[15], P1[0], P1[1],   pw1[2] = PKW(P0, 12), pw1[3] = PKW(P0, 14), pw1); \
    VRD(2); SBAR(); GAPA(C0 = MFMA32(kf[4], qr[2], C0),   P1[2], P1[3], P1[4], P1[5],     pw2[0] = PKW(P1, 0), pw2[1] = PKW(P1, 2), pw2); \
    VRD(6); SBAR(); GAPA(C1 = MFMA32(kf[5], qr[2], C1),   P1[6], P1[7], P1[8], P1[9],     pw2[2] = PKW(P1, 4), pw2[3] = PKW(P1, 6), pw2); \
    VRD(3); SBAR(); GAPA(C0 = MFMA32(kf[6], qr[3], C0),   P1[10], P1[11], P1[12], P1[13], pw3[0] = PKW(P1, 8), pw3[1] = PKW(P1, 10), pw3); \
    VRD(7); SBAR(); GAPA(C1 = MFMA32(kf[7], qr[3], C1),   P1[14], P1[15], 0.f, 0.f,       pw3[2] = PKW(P1, 12), pw3[3] = PKW(P1, 14), pw3); \
    l_reg += sacc; \
    if (GK) { DMA_K((t) + 3, sl_cur); } if (GV) { DMA_V((t) + 1, sl_next); } \
    CMASK(C0, C1, t); \
    { float a = MX3(C0[0], C0[1], C1[0]), b_ = MX3(C0[2], C0[3], C1[1]); a = MX3(a, C1[2], C1[3]); \
      _Pragma("unroll") for (int r = 4; r < 16; r += 4) { a = MX3(a, C0[r], C0[r + 1]); b_ = MX3(b_, C0[r + 2], C0[r + 3]); a = MX3(a, C1[r], C1[r + 1]); b_ = MX3(b_, C1[r + 2], C1[r + 3]); } \
      float rm = __builtin_fmaxf(a, b_); { auto rr = __builtin_amdgcn_permlane32_swap(__float_as_uint(rm), __float_as_uint(rm), false, false); rm = __builtin_fmaxf(__uint_as_float(rr[0]), __uint_as_float(rr[1])); } \
      resc = false; \
      if (__builtin_expect(__any(rm > (float)THRL), 0)) { const float dl = __builtin_fmaxf(rm, 0.f); mhat += dl; \
        _Pragma("unroll") for (int r = 0; r < 16; ++r) { C0[r] -= dl; C1[r] -= dl; } \
        _Pragma("unroll") for (int r = 0; r < 16; ++r) negm[r] = -mhat; asm volatile("" : "+v"(negm)); \
        const float f = __builtin_amdgcn_exp2f(-dl); l_reg *= f; if (hi == 0) wsf[r32] = f; resc = true; } } \
    SBAR(); \
    GAPB(o[0] = MFMA32(PAF(0), VFR(0), o[0]), C0, 0); \
    GAPB(o[1] = MFMA32(PAF(0), VFR(4), o[1]), C0, 4); \
    KRD(GL, 0); GAPB(o[0] = MFMA32(PAF(1), VFR(1), o[0]), C0, 8); \
    KRD(GL, 1); GAPB(o[1] = MFMA32(PAF(1), VFR(5), o[1]), C0, 12); \
    KRD(GL, 2); GAPB(o[0] = MFMA32(PAF(2), VFR(2), o[0]), C1, 0); \
    KRD(GL, 3); GAPB(o[1] = MFMA32(PAF(2), VFR(6), o[1]), C1, 4); \
    GAPB(o[0] = MFMA32(PAF(3), VFR(3), o[0]), C1, 8); \
    GAPB(o[1] = MFMA32(PAF(3), VFR(7), o[1]), C1, 12); \
    } while (0)
  int t = 1;
#undef CMASK
#define CMASK(P0, P1, t) do { if (lowband && (t) < 4) lmask(P0, P1, (t), qrel, hi, NEG); } while (0)
  for (; t + 5 < NT; t += 2) {
    STEP(pB0, pB1, pA0, pA1, t, true, true, true);     WAIT_BAR(2); RESC(); ROT();
    STEP(pA0, pA1, pB0, pB1, t + 1, true, true, true); WAIT_BAR(2); RESC(); ROT();
  }
#undef CMASK
#define CMASK(P0, P1, t) do { int jb_ = (t) - (NT - 4); if (jb_ >= 0) cmask(P0, P1, jb_, qrel, hi, NEG); if (lowband && (t) < 4) lmask(P0, P1, (t), qrel, hi, NEG); } while (0)
#define ENDW(tt) do { if ((tt) + 3 < NT) { WAIT_BAR(2); } else if ((tt) + 2 < NT) { WAIT_BAR(1); } else { WAIT_BAR(0); } } while (0)
  for (; t + 1 < NT; t += 2) {
    STEP(pB0, pB1, pA0, pA1, t, (t + 3 < NT), (t + 1 < NT), (t + 1 < NT));         ENDW(t);     RESC(); ROT();
    STEP(pA0, pA1, pB0, pB1, t + 1, (t + 4 < NT), (t + 2 < NT), (t + 2 < NT));     ENDW(t + 1); RESC(); ROT();
  }
  STEP(pB0, pB1, pA0, pA1, NT - 1, false, false, false); RESC();
  { float sacc = pB0[0] + pB0[1];
#pragma unroll
    for (int r = 2; r < 16; ++r) sacc += pB0[r];
#pragma unroll
    for (int r = 0; r < 16; ++r) sacc += pB1[r];
    l_reg += sacc;
    pw0 = (u32x4){PKW(pB0, 0), PKW(pB0, 2), PKW(pB0, 4), PKW(pB0, 6)}; pw1 = (u32x4){PKW(pB0, 8), PKW(pB0, 10), PKW(pB0, 12), PKW(pB0, 14)};
    pw2 = (u32x4){PKW(pB1, 0), PKW(pB1, 2), PKW(pB1, 4), PKW(pB1, 6)}; pw3 = (u32x4){PKW(pB1, 8), PKW(pB1, 10), PKW(pB1, 12), PKW(pB1, 14)};
    SBAR(); pv(o, vb0 + sl_cur, PAF(0), PAF(1), PAF(2), PAF(3)); }
#undef PKW
#undef PAF
#undef VFR
#undef PIN
#undef MX3
#undef GAPA
#undef GAPB
#undef EX
#undef VRD
#undef KRD
#undef STEP
#undef ENDW
  { auto rr = __builtin_amdgcn_permlane32_swap(__float_as_uint(l_reg), __float_as_uint(l_reg), false, false); l_reg = __uint_as_float(rr[0]) + __uint_as_float(rr[1]); }
  const long row0 = rowbase + q0 + wid * QBLK;
  if (hi == 0) { const float gte = ((const float*)(P.ws + WS_G))[(row0 + r32) * 24 + h * 3 + (MODE == 0 ? 1 : 2)]; wsf[32 + r32] = l_reg > 0.f ? gte * __builtin_amdgcn_rcpf(l_reg) : 0.f; }
  asm volatile("s_waitcnt lgkmcnt(0)" ::: "memory");
  float rli[16];
#pragma unroll
  for (int r = 0; r < 16; ++r) rli[r] = wsf[32 + crow(r, hi)];
  { LAS bf16_t* stg = (LAS bf16_t*)(shm + (MODE == 0 ? LDS_OS2 : LDS_OST)) + wid * 2048;
#pragma unroll
    for (int r = 0; r < 16; ++r) { const int orow = crow(r, hi);
#pragma unroll
      for (int d0 = 0; d0 < 2; ++d0) stg[orow * 64 + d0 * 32 + r32] = (bf16_t)f2bf(o[d0][r] * rli[r]); }
    asm volatile("s_waitcnt lgkmcnt(0)" ::: "memory");
    if (MODE == 1) {
      const LAS bf16_t* stg2 = (const LAS bf16_t*)(shm + LDS_OS2) + wid * 2048;
      const bf16_t* ocp = (const bf16_t*)(P.ws + WS_OC) + row0 * 512 + h * 64;
      const bf16_t* bgp = (const bf16_t*)(P.ws + WS_BG) + row0 * 512 + h * 64;
      bf16_t* hp = (bf16_t*)(P.ws + WS_H2) + row0 * 1024 + 512 + h * 64;
      int lane_e = lane; asm volatile("" : "+v"(lane_e));
#pragma unroll
      for (int i = 0; i < 4; ++i) { const int row = i * 8 + (lane_e >> 3), ch = lane_e & 7;
        const u32x4 a = *(const LAS u32x4*)(stg + row * 64 + ch * 8), s2 = *(const LAS u32x4*)(stg2 + row * 64 + ch * 8);
        const u32x4 oc = *(const u32x4*)(ocp + (long)row * 512 + ch * 8), bg = *(const u32x4*)(bgp + (long)row * 512 + ch * 8);
        u32x4 w;
        w.x = pk2((bflo(a.x) + bflo(s2.x) + bflo(oc.x)) * bflo(bg.x), (bfhi(a.x) + bfhi(s2.x) + bfhi(oc.x)) * bfhi(bg.x));
        w.y = pk2((bflo(a.y) + bflo(s2.y) + bflo(oc.y)) * bflo(bg.y), (bfhi(a.y) + bfhi(s2.y) + bfhi(oc.y)) * bfhi(bg.y));
        w.z = pk2((bflo(a.z) + bflo(s2.z) + bflo(oc.z)) * bflo(bg.z), (bfhi(a.z) + bfhi(s2.z) + bfhi(oc.z)) * bfhi(bg.z));
        w.w = pk2((bflo(a.w) + bflo(s2.w) + bflo(oc.w)) * bflo(bg.w), (bfhi(a.w) + bfhi(s2.w) + bfhi(oc.w)) * bfhi(bg.w));
        *(u32x4*)(hp + (long)row * 1024 + ch * 8) = w; }
    }
  }
  asm volatile("s_waitcnt vmcnt(0) lgkmcnt(0)\n\ts_barrier" ::: "memory");
#undef DMA_K
#undef DMA_V
#undef CMASK
#undef NEGSET
#undef START
#undef RESC
#undef ROT
}
#undef SBAR
#undef WAIT_BAR
}

__device__ __forceinline__ void phase_attn(const Prm& P, Ctx& C) {
    for (int task = C.bid; task < 256; task += C.G) sample_attn_task(P, C, task);
    __syncthreads();
    const bool bal = (C.G == 256);
    const int vcu = (C.bid & 7) * 32 + (C.bid >> 3), s = vcu & 7;
#pragma unroll 1
    for (int i = 0;; ++i) {
        int bh, qb;
        if (bal) { if (i >= 4) break; bh = vcu >> 3; qb = (i == 0) ? s : (i == 1) ? 15 - s : (i == 2) ? 16 + s : 31 - s; }
        else { const int u = i * C.G + C.bid; if (u >= 1024) break; bh = u >> 5; qb = u & 31; }
        at2::attn_unit<0, 8>(P, bh >> 3, bh & 7, qb, (LAS char*)C.lds, C.wave);
        at2::attn_unit<1, 8>(P, bh >> 3, bh & 7, qb, (LAS char*)C.lds, C.wave);
    }
}

constexpr int NPHASE = 12;
__global__ void __launch_bounds__(NTHR, 2) fwd(Prm P) {
    extern __shared__ __attribute__((aligned(16))) unsigned char lds_raw[];
    Ctx C; C.lds = (LAS unsigned char*)lds_raw; C.tid = threadIdx.x; C.lane = C.tid & 63; C.wave = __builtin_amdgcn_readfirstlane(C.tid >> 6); C.G = gridDim.x; C.bid = blockIdx.x;
#define FRESH() do { int l_; asm volatile("v_mbcnt_lo_u32_b32 %0, -1, 0\n\tv_mbcnt_hi_u32_b32 %0, -1, %0" : "=v"(l_)); C.lane = l_; C.tid = C.wave * 64 + l_; } while (0)
    volatile LAS unsigned* MISC = (volatile LAS unsigned*)(C.lds + MISC_OFF);
    if (C.tid < 32) MISC[C.tid] = 0u;
    __syncthreads();
    unsigned char* ws = P.ws;
    unsigned* ctl = (unsigned*)(ws + WS_CTL);
    XcdBarrier bar; bar.bar = ctl + CW_BAR; bar.x = 0; bar.st = nullptr;
    const int lo = P.ph_lo, hi = P.ph_hi;
    if (hi - lo > 1) bar = xcd_barrier_post(ctl + CW_BAR, MISC + 8);
#define IN(k) (lo <= (k) && (k) < hi)
#define SEAM(k) do { if (IN(k) && IN((k) + 1)) xcd_barrier(bar); } while (0)

    if (IN(0)) { FRESH(); phase_prologue(P, C); } SEAM(0);
    if (IN(1)) { FRESH();
        pg8::Gemm g{(const bf16_t*)(ws + WS_XA), (const bf16_t*)(ws + WS_W1T), 1024, 1024, 1024, 0};
        pg8::StaticOrder S; S.init(MA, N1, C.G, C.bid);
        Epi1 E{(bf16_t*)(ws + WS_U), (bf16_t*)(ws + WS_AG), (bf16_t*)(ws + WS_Q), (bf16_t*)(ws + WS_KS), (bf16_t*)(ws + WS_KW), (bf16_t*)(ws + WS_BG), (float*)(ws + WS_G), P.out};
        pg8::gemm_phase<Epi1, pg8::StaticOrder>(C.lds, g, S, E, C.tid);
    } SEAM(1);
    if (IN(2)) { FRESH(); phase_conv(P, C); } SEAM(2);
    if (IN(3)) { FRESH(); phase_cmp(P, C); } SEAM(3);
    if (IN(4)) { FRESH(); phase_attn(P, C); } SEAM(4);
    if (IN(5)) { FRESH();
        pg8::Gemm g{(const bf16_t*)(ws + WS_H2), (const bf16_t*)(ws + WS_W2T), 1024, 1024, 1024, 0};
        pg8::StaticOrder S; S.init(MA, 1024, C.G, C.bid);
        EpiF32 E{(float*)(ws + WS_DP), 1024};
        pg8::gemm_phase<EpiF32, pg8::StaticOrder>(C.lds, g, S, E, C.tid);
    } SEAM(5);
    if (IN(6)) { FRESH(); phase_ln<0>(P, C); } SEAM(6);
    if (IN(7)) { FRESH();
        pg8::Gemm g{(const bf16_t*)(ws + WS_X1A), (const bf16_t*)(ws + WS_W3T), 1024, 1024, 1024, 0};
        pg8::StaticOrder S; S.init(MA, 2048, C.G, C.bid);
        Epi3 E{(bf16_t*)(ws + WS_V), (bf16_t*)(ws + WS_GT), P.out};
        pg8::gemm_phase<Epi3, pg8::StaticOrder>(C.lds, g, S, E, C.tid);
    } SEAM(7);
    if (IN(8)) { FRESH(); phase_pool(P, C); } SEAM(8);
    if (IN(9)) { FRESH();
        pg8::Gemm g{(const bf16_t*)(ws + WS_DM), (const bf16_t*)(ws + WS_W4T), 1024, 256, 256, 256};
        pg8::StaticOrder S; S.init(MA, 1024, C.G, C.bid);
        Epi4 E{(const bf16_t*)(ws + WS_GT), P.pool_scale, (bf16_t*)(ws + WS_MX)};
        pg8::gemm_phase<Epi4, pg8::StaticOrder>(C.lds, g, S, E, C.tid);
    } SEAM(9);
    if (IN(10)) { FRESH();
        pg8::Gemm g{(const bf16_t*)(ws + WS_MX), (const bf16_t*)(ws + WS_W5T), 1024, 1024, 1024, 0};
        pg8::StaticOrder S; S.init(MA, 1024, C.G, C.bid);
        EpiF32 E{(float*)(ws + WS_DP2), 1024};
        pg8::gemm_phase<EpiF32, pg8::StaticOrder>(C.lds, g, S, E, C.tid);
    } SEAM(10);
    if (IN(11)) { FRESH(); phase_ln<1>(P, C); }
#undef IN
#undef FRESH
#undef SEAM
}

extern "C" void kernel_launch(void* const* d_in, const int* in_sizes, int n_in, void* d_out, int out_size, void* d_ws, size_t ws_size, hipStream_t stream) {
    static int grid = 0;
    if (grid == 0) {
        if (n_in != 21 || (size_t)out_size != O_TOTAL || ws_size < WS_END) { fprintf(stderr, "kernel_launch: unexpected sizes n_in %d out %d ws %zu\n", n_in, out_size, ws_size); grid = -1; return; }
        int dev = 0, cus = 0, per_cu = 0;
        if (hipGetDevice(&dev) != hipSuccess || hipDeviceGetAttribute(&cus, hipDeviceAttributeMultiprocessorCount, dev) != hipSuccess) { grid = -1; return; }
        if (hipFuncSetAttribute((const void*)fwd, hipFuncAttributeMaxDynamicSharedMemorySize, LDS_BYTES) != hipSuccess) { fprintf(stderr, "kernel_launch: hipFuncSetAttribute failed\n"); grid = -1; return; }
        if (hipOccupancyMaxActiveBlocksPerMultiprocessor(&per_cu, (const void*)fwd, NTHR, LDS_BYTES) != hipSuccess || per_cu < 1) fprintf(stderr, "kernel_launch: occupancy query says %d\n", per_cu);
        (void)hipGetLastError();
        grid = cus;
    }
    if (grid < 0) return;
    (void)hipMemsetAsync((char*)d_ws + WS_CTL, 0, CTL_ZERO_BYTES, stream);
    Prm p{};
    p.x_prompt = (const float*)d_in[0]; p.x_sample = (const float*)d_in[1]; p.cache_c = (const float*)d_in[2]; p.cache_s = (const float*)d_in[3];
    p.state_win = (const float*)d_in[4]; p.state_conv = (const float*)d_in[5]; p.state_pool = (const float*)d_in[6]; p.page_table = (const int*)d_in[7];
    p.w_in_even = (const float*)d_in[8]; p.w_cmp = (const float*)d_in[9]; p.conv_w = (const float*)d_in[10]; p.conv_b = (const float*)d_in[11];
    p.conv_ln_g = (const float*)d_in[12]; p.conv_ln_b = (const float*)d_in[13]; p.w_out_even = (const float*)d_in[14]; p.w_in_odd = (const float*)d_in[15];
    p.w_grp = (const float*)d_in[16]; p.pool_scale = (const float*)d_in[17]; p.w_out_odd = (const float*)d_in[18]; p.ln_g = (const float*)d_in[19]; p.ln_b = (const float*)d_in[20];
    p.out = (float*)d_out; p.ws = (unsigned char*)d_ws;
#if N_LAUNCH_MODE == 1
    p.ph_lo = 0; p.ph_hi = NPHASE;
    hipLaunchKernelGGL(fwd, dim3(grid), dim3(NTHR), LDS_BYTES, stream, p);
#else
    for (int ph = 0; ph < NPHASE; ++ph) { p.ph_lo = ph; p.ph_hi = ph + 1; hipLaunchKernelGGL(fwd, dim3(grid), dim3(NTHR), LDS_BYTES, stream, p); }
#endif
}
```

```cpp
#include <hip/hip_runtime.h>
#include <cstdio>
#include <cstdint>

#ifndef N_LAUNCH_MODE
#define N_LAUNCH_MODE 1
#endif

#ifndef REPEAT_MASK
#define REPEAT_MASK 0
#endif
#define LAS __attribute__((address_space(3)))
#define GAS __attribute__((address_space(1)))
typedef unsigned short bf16_t;
typedef short bf16x8 __attribute__((ext_vector_type(8)));
typedef short s16x4 __attribute__((ext_vector_type(4)));
typedef float f32x4 __attribute__((ext_vector_type(4)));
typedef float f32x2 __attribute__((ext_vector_type(2)));
typedef float f32x16 __attribute__((ext_vector_type(16)));
typedef unsigned u32x4 __attribute__((ext_vector_type(4)));
typedef unsigned u32x2 __attribute__((ext_vector_type(2)));

constexpr int DM = 1024, NBATCH = 4, SEQ = 8192, MP = NBATCH * SEQ, DB = 32, DS = 4, MS = DB * DS, MR = MP + MS, MA = 33024;
constexpr int PAST = 16384, PAGE = 128, NPAGES = PAST / PAGE;
constexpr int WC = 512, WA = 512, KVW = 256, E_IN = 3352, N1 = 3584;
constexpr float LN_EPS = 1e-5f, ALPHA = 1.41421356237309515f;
constexpr float C2 = 0.125f * 1.4426950408889634f;
constexpr float NEGB = -1e30f;
constexpr size_t O_Y = 0, O_YS = 33554432, O_KC = O_YS + 131072, O_KSEL = O_KC + 8388608, O_WIN = O_KSEL + 8388608, O_CONV = O_WIN + 524288,
                 O_POOL = O_CONV + 61440, O_KCS = O_POOL + 61440, O_KSS = O_KCS + 32768, O_WINS = O_KSS + 32768, O_CONVS = O_WINS + 4194304,
                 O_POOLS = O_CONVS + 491520, O_TOTAL = O_POOLS + 491520;
constexpr size_t MiB = 1u << 20;
constexpr size_t WS_CTL = 0, CTL_ZERO_BYTES = 1 * MiB;
constexpr size_t WS_W1T = 2 * MiB, WS_W2T = 9 * MiB, WS_W3T = 11 * MiB, WS_W4T = 15 * MiB, WS_W5T = 16 * MiB, WS_KC = 18 * MiB, WS_SELM = 19 * MiB, WS_SELMS = 20 * MiB,
                 WS_G = 21 * MiB, WS_KCS = 25 * MiB, WS_XA = 48 * MiB, WS_U = 113 * MiB, WS_AG = 146 * MiB, WS_Q = 179 * MiB, WS_BG = 212 * MiB, WS_KS = 245 * MiB,
                 WS_KW = 262 * MiB, WS_OC = 279 * MiB, WS_H2 = 312 * MiB, WS_DP = 377 * MiB, WS_X1 = 507 * MiB, WS_X1A = 636 * MiB, WS_V = 701 * MiB, WS_GT = 766 * MiB,
                 WS_DM = 831 * MiB, WS_MX = 896 * MiB, WS_DP2 = 961 * MiB, WS_END = 1091 * MiB;
constexpr int CW_BAR = 4096;

constexpr int NWAVES = 8, NTHR = 512;
constexpr int LDS_BYTES = 147456, RING_BYTES = 131072, MISC_OFF = LDS_BYTES - 256;

struct Prm {
    const float *x_prompt, *x_sample, *cache_c, *cache_s, *state_win, *state_conv, *state_pool;
    const int* page_table;
    const float *w_in_even, *w_cmp, *conv_w, *conv_b, *conv_ln_g, *conv_ln_b, *w_out_even, *w_in_odd, *w_grp, *pool_scale, *w_out_odd, *ln_g, *ln_b;
    float* out; unsigned char* ws;
    int ph_lo, ph_hi;
};

__device__ __forceinline__ unsigned f2bf(float f) { unsigned u = __builtin_bit_cast(unsigned, f); return (u + 0x7fffu + ((u >> 16) & 1u)) >> 16; }
__device__ __forceinline__ unsigned pk2(float lo, float hi) { return f2bf(lo) | (f2bf(hi) << 16); }
__device__ __forceinline__ float bf2f(unsigned short h) { return __builtin_bit_cast(float, (unsigned)h << 16); }
__device__ __forceinline__ float bflo(unsigned w) { return __builtin_bit_cast(float, w << 16); }
__device__ __forceinline__ float bfhi(unsigned w) { return __builtin_bit_cast(float, w & 0xffff0000u); }
__device__ __forceinline__ float sigmoidf_(float x) { return __builtin_amdgcn_rcpf(1.0f + __expf(-x)); }
__device__ __forceinline__ float siluf_(float x) { return x * sigmoidf_(x); }
__device__ __forceinline__ float ex2(float x) { return __builtin_amdgcn_exp2f(x); }
__device__ __forceinline__ float wave_sum(float v) {
#pragma unroll
    for (int o = 1; o < 64; o <<= 1) v += __shfl_xor(v, o);
    return v;
}
__device__ __forceinline__ float wave_max(float v) {
#pragma unroll
    for (int o = 1; o < 64; o <<= 1) v = fmaxf(v, __shfl_xor(v, o));
    return v;
}
__device__ __forceinline__ int crow(int r, int hi) { return (r & 3) + 8 * (r >> 2) + 4 * hi; }
#define LDS_WAIT() asm volatile("s_waitcnt lgkmcnt(0)" ::: "memory")

namespace pg8 {
constexpr int BM = 256, BK = 64, HALF = 128, HTB = HALF * BK * 2, STAGE_BYTES = 8 * HTB, NXCD = 8, WGM = 8;
__host__ __device__ __forceinline__ int lds_byte(int r, int c) { const int st = (r >> 4) * 2 + (c >> 5), rr = r & 15, cc = c & 31, ob = rr * 64 + cc * 2; return st * 1024 + (ob ^ (((ob >> 9) & 1) << 5)); }
__host__ __device__ __forceinline__ void stage_rc(int b, int& R, int& C) { const int st = b / 1024, sb = b % 1024, swz = sb ^ (((sb >> 9) & 1) << 5); R = (st >> 1) * 16 + swz / 64; C = (st & 1) * 32 + (swz % 64) / 2; }
__host__ __device__ __forceinline__ int perm32(int rho) { const int n = rho >> 4, i = rho & 15; return 8 * (i >> 2) + 4 * n + (i & 3); }
struct Unit { int pm, pn; };
struct Gemm { const bf16_t* A; const bf16_t* Bt; int lda, ldb, K, a_pn_off; };
struct StaticOrder {
    int nM, nN, nwg, G, c;
    __host__ __device__ void init(int M, int N, int G_, int c_) { nM = M / BM; nN = N / BM; nwg = nM * nN; G = G_; c = c_; }
    __host__ __device__ bool next(int i, Unit& u) const {
        const long L = (long)i * G + c; if (L >= nwg) return false;
        int wgid = (int)L; { const int q = nwg / NXCD, r = nwg % NXCD, xcd = wgid % NXCD, off = wgid / NXCD; wgid = (xcd < r ? xcd * (q + 1) : r * (q + 1) + (xcd - r) * q) + off; }
        const int nig = WGM * nN, gid = wgid / nig, fm = gid * WGM, gsz = (nM - fm) < WGM ? (nM - fm) : WGM;
        u.pm = fm + ((wgid % nig) % gsz); u.pn = (wgid % nig) / gsz; return true;
    }
};
template <class Epi, class Sched, bool ALIGN_EPI = true>
__device__ __forceinline__ void gemm_phase(LAS unsigned char* lds, const Gemm g, const Sched& S, const Epi& E, const int tid) {
    const int wid = __builtin_amdgcn_readfirstlane(tid >> 6), lane = tid & 63, wr = wid >> 2, wc = wid & 3, fr = lane & 15, fq = lane >> 4;
    const int K = g.K, nt = K / BK;
    unsigned voffA[2], voffB[2];
#pragma unroll
    for (int i = 0; i < 2; ++i) { int R, C; stage_rc(tid * 16 + i * 8192, R, C); const int Rb = Epi::PERM ? ((R & ~31) + perm32(R & 31)) : R;
        voffA[i] = (unsigned)(R * g.lda + C) * 2u; voffB[i] = (unsigned)(Rb * g.ldb + C) * 2u; }
    const size_t kstep = (size_t)(BK * 2);
    const size_t hstepA = (size_t)HALF * g.lda * 2, hstepB = (size_t)HALF * g.ldb * 2;
    const size_t tstepA = 2 * hstepA, tstepB = 2 * hstepB;
    const unsigned ldsw = (unsigned)wid * 1024u;
    const int aoff = lds_byte(wr * 64 + fr, fq * 8), boff = lds_byte(wc * 32 + fr, fq * 8);
#define PG8_SA(b, h) (((b) * 2 + (h)) * HTB)
#define PG8_SB(b, h) ((4 + (b) * 2 + (h)) * HTB)
#define PG8_STAGE(bufoff, gbase, voff) do { _Pragma("unroll") for (int _i = 0; _i < 2; ++_i) \
        __builtin_amdgcn_global_load_lds((const unsigned*)((const char*)(gbase) + (voff)[_i]), (LAS unsigned*)(lds + (bufoff) + ldsw + _i * 8192), 16, 0, 0); } while (0)
#define PG8_LDA(dst, b, h) do { _Pragma("unroll") for (int m = 0; m < 4; ++m) _Pragma("unroll") for (int k = 0; k < 2; ++k) dst[m][k] = *(const LAS bf16x8*)(lds + PG8_SA(b, h) + aoff + m * 2048 + k * 1024); } while (0)
#define PG8_LDB(dst, b, h) do { _Pragma("unroll") for (int n = 0; n < 2; ++n) _Pragma("unroll") for (int k = 0; k < 2; ++k) dst[n][k] = *(const LAS bf16x8*)(lds + PG8_SB(b, h) + boff + n * 2048 + k * 1024); } while (0)
#define PG8_MMA(ai, bj, At, Bt) do { __builtin_amdgcn_s_setprio(1); _Pragma("unroll") for (int m = 0; m < 4; ++m) _Pragma("unroll") for (int n = 0; n < 2; ++n) _Pragma("unroll") for (int k = 0; k < 2; ++k) \
        acc[ai][bj][m][n] = __builtin_amdgcn_mfma_f32_16x16x32_bf16(Bt[n][k], At[m][k], acc[ai][bj][m][n], 0, 0, 0); __builtin_amdgcn_s_setprio(0); } while (0)
#define PG8_WAIT_V(n) asm volatile("s_waitcnt vmcnt(" #n ")" ::: "memory")
#define PG8_WAIT_L(n) asm volatile("s_waitcnt lgkmcnt(" #n ")" ::: "memory")
#define PG8_BAR __builtin_amdgcn_s_barrier()
#define PG8_SCHED __builtin_amdgcn_sched_barrier(0)
    Unit cur, nxt; int ui = 0;
    if (!S.next(0, cur)) return;
    f32x4 acc[2][2][4][2];
#pragma unroll
    for (int a = 0; a < 2; ++a)
#pragma unroll
        for (int b = 0; b < 2; ++b)
#pragma unroll
            for (int m = 0; m < 4; ++m)
#pragma unroll
                for (int n = 0; n < 2; ++n) acc[a][b][m][n] = (f32x4){0.f, 0.f, 0.f, 0.f};
    bf16x8 At[4][2], B0[2][2], B1[2][2];
    const char* cA = (const char*)g.A + (size_t)cur.pm * tstepA + (size_t)cur.pn * g.a_pn_off * 2; const char* cB = (const char*)g.Bt + (size_t)cur.pn * tstepB;
    {
        PG8_STAGE(PG8_SB(0, 0), cB, voffB); PG8_STAGE(PG8_SB(0, 1), cB + hstepB, voffB); PG8_STAGE(PG8_SA(0, 0), cA, voffA); PG8_STAGE(PG8_SA(0, 1), cA + hstepA, voffA);
        if (wr == 1) PG8_BAR;
        PG8_WAIT_V(2); PG8_BAR;
        PG8_STAGE(PG8_SB(1, 0), cB + kstep, voffB); PG8_STAGE(PG8_SA(1, 0), cA + kstep, voffA); PG8_STAGE(PG8_SB(1, 1), cB + hstepB + kstep, voffB);
        PG8_WAIT_V(6); PG8_BAR;
    }
    for (;;) {
        const bool has_next = S.next(ui + 1, nxt);
        const char* nA = has_next ? (const char*)g.A + (size_t)nxt.pm * tstepA + (size_t)nxt.pn * g.a_pn_off * 2 : cA; const char* nB = has_next ? (const char*)g.Bt + (size_t)nxt.pn * tstepB : cB;
        for (int t = 0; t < nt; t += 2) {
            const bool last = (t == nt - 2);
            const char* a1 = cA + (size_t)(t + 1) * kstep;
            const char* a2 = last ? nA : cA + (size_t)(t + 2) * kstep; const char* b2 = last ? nB : cB + (size_t)(t + 2) * kstep;
            const char* a3 = a2 + kstep; const char* b3 = b2 + kstep;
            PG8_LDB(B0, 0, 0); PG8_LDB(B1, 0, 1); PG8_SCHED; PG8_LDA(At, 0, 0); PG8_STAGE(PG8_SA(1, 1), a1 + hstepA, voffA);
            PG8_WAIT_V(8); PG8_WAIT_L(0); PG8_BAR; PG8_MMA(0, 0, At, B0); PG8_MMA(0, 1, At, B1); PG8_BAR; PG8_SCHED;
            PG8_LDA(At, 0, 1); PG8_STAGE(PG8_SB(0, 0), b2, voffB); PG8_STAGE(PG8_SB(0, 1), b2 + hstepB, voffB); PG8_STAGE(PG8_SA(0, 0), a2, voffA);
            PG8_WAIT_V(8); PG8_WAIT_L(0); PG8_BAR; PG8_MMA(1, 0, At, B0); PG8_MMA(1, 1, At, B1); PG8_BAR; PG8_SCHED;
            PG8_LDB(B0, 1, 0); PG8_LDB(B1, 1, 1); PG8_SCHED; PG8_LDA(At, 1, 0); PG8_STAGE(PG8_SA(0, 1), a2 + hstepA, voffA);
            PG8_WAIT_V(8); PG8_WAIT_L(0); PG8_BAR; PG8_MMA(0, 0, At, B0); PG8_MMA(0, 1, At, B1); PG8_BAR; PG8_SCHED;
            PG8_LDA(At, 1, 1); PG8_STAGE(PG8_SB(1, 0), b3, voffB); PG8_STAGE(PG8_SB(1, 1), b3 + hstepB, voffB); PG8_STAGE(PG8_SA(1, 0), a3, voffA);
            PG8_WAIT_V(8); PG8_WAIT_L(0); PG8_BAR; PG8_MMA(1, 0, At, B0); PG8_MMA(1, 1, At, B1); PG8_BAR; PG8_SCHED;
        }
        if constexpr (ALIGN_EPI) { if (wr == 0) PG8_BAR; }
        E(acc, cur, wr, wc, fr, fq);
        if (!has_next) break;
#pragma unroll
        for (int a = 0; a < 2; ++a)
#pragma unroll
            for (int b = 0; b < 2; ++b)
#pragma unroll
                for (int m = 0; m < 4; ++m)
#pragma unroll
                    for (int n = 0; n < 2; ++n) acc[a][b][m][n] = (f32x4){0.f, 0.f, 0.f, 0.f};
        cur = nxt; cA = nA; cB = nB; ++ui;
        if constexpr (ALIGN_EPI) { if (wr == 1) PG8_BAR; }
    }
    PG8_WAIT_V(0);
    if constexpr (!ALIGN_EPI) { if (wr == 0) PG8_BAR; }
    PG8_BAR;
#undef PG8_SA
#undef PG8_SB
#undef PG8_STAGE
#undef PG8_LDA
#undef PG8_LDB
#undef PG8_MMA
#undef PG8_WAIT_V
#undef PG8_WAIT_L
#undef PG8_BAR
#undef PG8_SCHED
}
}

__device__ __forceinline__ void st8bf(bf16_t* p, f32x4 a, f32x4 b) { u32x4 w; w.x = pk2(a[0], a[1]); w.y = pk2(a[2], a[3]); w.z = pk2(b[0], b[1]); w.w = pk2(b[2], b[3]); *(u32x4*)p = w; }
__device__ __forceinline__ f32x4 sig4(f32x4 v) { f32x4 r; r[0] = sigmoidf_(v[0]); r[1] = sigmoidf_(v[1]); r[2] = sigmoidf_(v[2]); r[3] = sigmoidf_(v[3]); return r; }

struct Epi1 {
    static constexpr bool PERM = true;
    bf16_t *U, *AG, *Q, *KS, *KW, *BG; float* G; float* out;
    __device__ __forceinline__ void operator()(const f32x4 (&acc)[2][2][4][2], const pg8::Unit& u, int wr, int wc, int fr, int fq) const {
        const int pn = u.pn, cw = wc * 32 + 8 * fq;
#pragma unroll
        for (int ai = 0; ai < 2; ++ai)
#pragma unroll
            for (int m = 0; m < 4; ++m) {
                const int row = u.pm * 256 + ai * 128 + wr * 64 + m * 16 + fr;
                if (row >= MR) continue;
                const bool smp = row >= MP;
                const int b = smp ? (row - MP) >> 2 : row >> 13, t = smp ? (row - MP) & 3 : row & (SEQ - 1);
                if (pn < 4) {
                    f32x4 v0 = acc[ai][0][m][0] * sig4(acc[ai][1][m][0]), v1 = acc[ai][0][m][1] * sig4(acc[ai][1][m][1]);
                    const int col = pn * 128 + cw;
                    st8bf(U + (size_t)row * 512 + col, v0, v1);
                    float* o = nullptr;
                    if (!smp) { if (t >= SEQ - 30) o = out + O_CONV + ((size_t)b * 30 + (t - (SEQ - 30))) * 512 + col; }
                    else o = out + O_CONVS + ((size_t)b * 30 + 26 + t) * 512 + col;
                    if (o) { *(f32x4*)o = v0; *(f32x4*)(o + 4) = v1; }
                } else if (pn < 6 || pn == 11 || pn == 12) {
                    bf16_t* dst = (pn < 6 ? AG : BG) + (size_t)row * 512 + (pn < 6 ? pn - 4 : pn - 11) * 256 + cw;
#pragma unroll
                    for (int bj = 0; bj < 2; ++bj) { const f32x4 a = acc[ai][bj][m][0], c = acc[ai][bj][m][1]; st8bf(dst + bj * 128, a * sig4(a), c * sig4(c)); }
                } else if (pn < 8) {
                    bf16_t* dst = Q + (size_t)row * 512 + (pn - 6) * 256 + cw;
#pragma unroll
                    for (int bj = 0; bj < 2; ++bj) st8bf(dst + bj * 128, acc[ai][bj][m][0] * C2, acc[ai][bj][m][1] * C2);
                } else if (pn == 8) {
                    float* o = (smp ? out + O_KCS + (size_t)(row - MP) * 256 : out + O_KC + (size_t)row * 256) + cw;
#pragma unroll
                    for (int bj = 0; bj < 2; ++bj) { *(f32x4*)(o + bj * 128) = acc[ai][bj][m][0]; *(f32x4*)(o + bj * 128 + 4) = acc[ai][bj][m][1]; }
                } else if (pn == 9) {
                    float* o = (smp ? out + O_KSS + (size_t)(row - MP) * 256 : out + O_KSEL + (size_t)row * 256) + cw;
                    bf16_t* dst = KS + (size_t)row * 256 + cw;
#pragma unroll
                    for (int bj = 0; bj < 2; ++bj) { *(f32x4*)(o + bj * 128) = acc[ai][bj][m][0]; *(f32x4*)(o + bj * 128 + 4) = acc[ai][bj][m][1]; st8bf(dst + bj * 128, acc[ai][bj][m][0], acc[ai][bj][m][1]); }
                } else if (pn == 10) {
                    float* o = nullptr;
                    if (!smp) { if (t >= SEQ - 512) o = out + O_WIN + ((size_t)b * 512 + (t - (SEQ - 512))) * 256 + cw; }
                    else o = out + O_WINS + ((size_t)b * 512 + 508 + t) * 256 + cw;
                    bf16_t* dst = KW + (size_t)row * 256 + cw;
#pragma unroll
                    for (int bj = 0; bj < 2; ++bj) { st8bf(dst + bj * 128, acc[ai][bj][m][0], acc[ai][bj][m][1]);
                        if (o) { *(f32x4*)(o + bj * 128) = acc[ai][bj][m][0]; *(f32x4*)(o + bj * 128 + 4) = acc[ai][bj][m][1]; } }
                } else {
                    if (wc == 0 && fq < 3) { float* o = G + (size_t)row * 24 + 8 * fq; *(f32x4*)o = sig4(acc[ai][0][m][0]); *(f32x4*)(o + 4) = sig4(acc[ai][0][m][1]); }
                }
            }
    }
};
struct EpiF32 {
    static constexpr bool PERM = false;
    float* O; int ldc;
    __device__ __forceinline__ void operator()(const f32x4 (&acc)[2][2][4][2], const pg8::Unit& u, int wr, int wc, int fr, int fq) const {
#pragma unroll
        for (int ai = 0; ai < 2; ++ai)
#pragma unroll
            for (int m = 0; m < 4; ++m) {
                const int row = u.pm * 256 + ai * 128 + wr * 64 + m * 16 + fr;
                if (row >= MR) continue;
                float* o = O + (size_t)row * ldc + u.pn * 256 + wc * 32 + 4 * fq;
#pragma unroll
                for (int bj = 0; bj < 2; ++bj)
#pragma unroll
                    for (int n = 0; n < 2; ++n) *(f32x4*)(o + bj * 128 + n * 16) = acc[ai][bj][m][n];
            }
    }
};
struct Epi3 {
    static constexpr bool PERM = true;
    bf16_t *V, *GT; float* out;
    __device__ __forceinline__ void operator()(const f32x4 (&acc)[2][2][4][2], const pg8::Unit& u, int wr, int wc, int fr, int fq) const {
        const int pn = u.pn, cw = wc * 32 + 8 * fq;
#pragma unroll
        for (int ai = 0; ai < 2; ++ai)
#pragma unroll
            for (int m = 0; m < 4; ++m) {
                const int row = u.pm * 256 + ai * 128 + wr * 64 + m * 16 + fr;
                if (row >= MR) continue;
                const bool smp = row >= MP;
                const int b = smp ? (row - MP) >> 2 : row >> 13, t = smp ? (row - MP) & 3 : row & (SEQ - 1);
                if (pn < 4) {
                    const int col = pn * 256 + cw;
                    float* o = nullptr;
                    if (!smp) { if (t >= SEQ - 15) o = out + O_POOL + ((size_t)b * 15 + (t - (SEQ - 15))) * 1024 + col; }
                    else o = out + O_POOLS + ((size_t)b * 15 + 11 + t) * 1024 + col;
#pragma unroll
                    for (int bj = 0; bj < 2; ++bj) { st8bf(V + (size_t)row * 1024 + col + bj * 128, acc[ai][bj][m][0], acc[ai][bj][m][1]);
                        if (o) { *(f32x4*)(o + bj * 128) = acc[ai][bj][m][0]; *(f32x4*)(o + bj * 128 + 4) = acc[ai][bj][m][1]; } }
                } else {
                    bf16_t* dst = GT + (size_t)row * 1024 + (pn - 4) * 256 + cw;
#pragma unroll
                    for (int bj = 0; bj < 2; ++bj) { const f32x4 a = acc[ai][bj][m][0], c = acc[ai][bj][m][1]; st8bf(dst + bj * 128, a * sig4(a), c * sig4(c)); }
                }
            }
    }
};
struct Epi4 {
    static constexpr bool PERM = true;
    const bf16_t* GT; const float* scale; bf16_t* MX;
    __device__ __forceinline__ void operator()(const f32x4 (&acc)[2][2][4][2], const pg8::Unit& u, int wr, int wc, int fr, int fq) const {
        const int cw = u.pn * 256 + wc * 32 + 8 * fq;
#pragma unroll
        for (int ai = 0; ai < 2; ++ai)
#pragma unroll
            for (int m = 0; m < 4; ++m) {
                const int row = u.pm * 256 + ai * 128 + wr * 64 + m * 16 + fr;
                if (row >= MR) continue;
#pragma unroll
                for (int bj = 0; bj < 2; ++bj) {
                    const int col = cw + bj * 128;
                    const u32x4 gw = *(const u32x4*)(GT + (size_t)row * 1024 + col);
                    const f32x4 s0 = *(const f32x4*)(scale + col), s1 = *(const f32x4*)(scale + col + 4);
                    f32x4 a = acc[ai][bj][m][0] * s0, c = acc[ai][bj][m][1] * s1;
                    a[0] *= bflo(gw.x); a[1] *= bfhi(gw.x); a[2] *= bflo(gw.y); a[3] *= bfhi(gw.y);
                    c[0] *= bflo(gw.z); c[1] *= bfhi(gw.z); c[2] *= bflo(gw.w); c[3] *= bfhi(gw.w);
                    st8bf(MX + (size_t)row * 1024 + col, a, c);
                }
            }
    }
};
#define XB_TMO      128
#define XB_XCNT(j)  (256  + 64 * (j))
#define XB_XSUB(j)  (1280 + 64 * (j))
#define XB_XGEN(j)  (2304 + 64 * (j))
#define XB_TOP      3328
#define XB_TOPGEN   3392
#define XCD_BAR_WORDS 3456
#define XB_SPIN_CAP (1u << 18)

__device__ __forceinline__ unsigned xb_ld(unsigned* p)              { return __hip_atomic_load(p, __ATOMIC_RELAXED, __HIP_MEMORY_SCOPE_AGENT); }
__device__ __forceinline__ unsigned xb_add(unsigned* p, unsigned v) { return __hip_atomic_fetch_add(p, v, __ATOMIC_RELAXED, __HIP_MEMORY_SCOPE_AGENT); }
__device__ __forceinline__ unsigned xb_xcc_id() { return (unsigned)__builtin_amdgcn_s_getreg((3 << 11) | 20) & 0xFu; }
#define XB_SPIN(cond, bar) do { unsigned _sp = 0; while (cond) { __builtin_amdgcn_s_sleep(1); \
    if ((++_sp & 255u) == 0u) { if (xb_ld(&(bar)[XB_TMO])) break; if (_sp > XB_SPIN_CAP) { atomicAdd(&(bar)[XB_TMO], 1u); break; } } } } while (0)

struct XcdBarrier {
    unsigned* bar; unsigned x;
    volatile LAS unsigned* st;
};

__device__ __forceinline__ XcdBarrier xcd_barrier_post(unsigned* bar, volatile LAS unsigned* st) {
    XcdBarrier b; b.bar = bar; b.x = xb_xcc_id(); b.st = st;
    if (threadIdx.x == 0) (void)xb_add(&bar[XB_XCNT(b.x)], 1u);
    return b;
}
__device__ __forceinline__ void xcd_barrier_complete(unsigned* bar, unsigned x, unsigned& nloc, unsigned& nx) {
    const unsigned G = gridDim.x * gridDim.y * gridDim.z;
    unsigned sum, cnt, mine, sp = 0u;
    for (;;) {
        sum = 0u; cnt = 0u; mine = 0u;
#pragma unroll
        for (unsigned j = 0; j < 16; ++j) { const unsigned c = xb_ld(&bar[XB_XCNT(j)]); sum += c; cnt += (c > 0u) ? 1u : 0u; mine = (j == x) ? c : mine; }
        if (sum == G) break;
        __builtin_amdgcn_s_sleep(1);
        if ((++sp & 255u) == 0u) { if (xb_ld(&bar[XB_TMO])) break; if (sp > XB_SPIN_CAP) { atomicAdd(&bar[XB_TMO], 1u); break; } }
    }
    nloc = mine > 0u ? mine : 1u; nx = cnt > 0u ? cnt : 1u;
}

__device__ __forceinline__ void xcd_barrier(const XcdBarrier& b) {
    asm volatile("s_waitcnt vmcnt(0)" ::: "memory");
    __syncthreads();
    if (threadIdx.x == 0) {
        unsigned* bar = b.bar;
        __builtin_amdgcn_s_waitcnt(0);
        unsigned nloc = b.st[0], nx = b.st[1];
        if (nloc == 0u) { xcd_barrier_complete(bar, b.x, nloc, nx); b.st[0] = nloc; b.st[1] = nx; }
        const unsigned old = xb_add(&bar[XB_XSUB(b.x)], 1u);
        const unsigned gen = old / nloc;
        if (old + 1u == (gen + 1u) * nloc) {
            __builtin_amdgcn_fence(__ATOMIC_RELEASE, "agent");
            asm volatile("s_waitcnt vmcnt(0)" ::: "memory");
            const unsigned og = xb_add(&bar[XB_TOP], 1u);
            const unsigned tg = og / nx;
            if (og + 1u == (tg + 1u) * nx) xb_add(&bar[XB_TOPGEN], 1u);
            else XB_SPIN(xb_ld(&bar[XB_TOPGEN]) == tg, bar);
            __builtin_amdgcn_fence(__ATOMIC_ACQUIRE, "agent");
            xb_add(&bar[XB_XGEN(b.x)], 1u);
            asm volatile("s_waitcnt vmcnt(0)" ::: "memory");
        } else {
            XB_SPIN(xb_ld(&bar[XB_XGEN(b.x)]) == gen, bar);
            __builtin_amdgcn_fence(__ATOMIC_ACQUIRE, "agent");
            asm volatile("s_waitcnt vmcnt(0)" ::: "memory");
        }
    }
    __syncthreads();
}

struct Ctx { LAS unsigned char* lds; int tid, lane, wave, G, bid; };

__device__ __forceinline__ int w1_src_col(int blk) {
    const int p = blk >> 3, r = (blk & 7) * 32;
    if (p < 4) return r < 128 ? 128 * p + r : 512 + 128 * p + (r - 128);
    if (p < 6) return 1024 + 256 * (p - 4) + r;
    if (p < 8) return 1536 + 256 * (p - 6) + r;
    if (p == 8) return 2048 + r;
    if (p == 9) return 2304 + r;
    if (p == 10) return 2560 + r;
    if (p < 13) return 2840 + 256 * (p - 11) + r;
    return r == 0 ? 2816 : -1;
}
__device__ __forceinline__ void p0_transpose_item(const float* W, int Nsrc, bf16_t* WT, int Kdst, int k0, int src_col0, int dst_row0, LAS float* scr, int lane) {
#pragma unroll 8
    for (int i = 0; i < 32; ++i) { const int kk = 2 * i + (lane >> 5); scr[kk * 33 + (lane & 31)] = (src_col0 >= 0) ? W[(size_t)(k0 + kk) * Nsrc + src_col0 + (lane & 31)] : 0.f; }
    LDS_WAIT();
    const int c = lane & 7;
#pragma unroll
    for (int j = 0; j < 4; ++j) { const int n = (lane >> 3) + 8 * j; const LAS float* s = scr + (8 * c) * 33 + n;
        u32x4 o; o.x = pk2(s[0 * 33], s[1 * 33]); o.y = pk2(s[2 * 33], s[3 * 33]); o.z = pk2(s[4 * 33], s[5 * 33]); o.w = pk2(s[6 * 33], s[7 * 33]);
        *(u32x4*)(WT + (size_t)(dst_row0 + n) * Kdst + k0 + 8 * c) = o; }
    LDS_WAIT();
}
template <class RowPtr>
__device__ __forceinline__ void compress_task(const RowPtr& rp, int nrows, int p, const LAS float* wl, bf16_t* dst, int nmax, int lane) {
    f32x4 Aprev = (f32x4){0.f, 0.f, 0.f, 0.f};
    for (int i = 0; i <= 8; ++i) {
        const int r0 = 128 * p + 16 * i;
        if (r0 >= nrows) break;
        f32x4 v[16];
#pragma unroll
        for (int j = 0; j < 16; ++j) v[j] = __builtin_nontemporal_load((const f32x4*)(rp(r0 + j)) + lane);
        f32x4 A = (f32x4){0.f, 0.f, 0.f, 0.f}, B = A;
#pragma unroll
        for (int j = 0; j < 16; ++j) { const f32x4 wa = *(const LAS f32x4*)(wl + j * 256 + 4 * lane), wb = *(const LAS f32x4*)(wl + (16 + j) * 256 + 4 * lane); A += v[j] * wa; B += v[j] * wb; }
        if (i >= 1) { const int n = 8 * p + i - 1; if (n < nmax) { const f32x4 s = Aprev + B; u32x2 o; o.x = pk2(s[0], s[1]); o.y = pk2(s[2], s[3]); *(u32x2*)(dst + (size_t)n * 256 + 4 * lane) = o; } }
        Aprev = A;
    }
}
struct RowsPaged { const float* cache; const int* pt; __device__ __forceinline__ const float* operator()(int r) const { return cache + ((size_t)pt[r >> 7] * PAGE + (r & (PAGE - 1))) * 256; } };
struct RowsFlat { const float* base; __device__ __forceinline__ const float* operator()(int r) const { return base + (size_t)r * 256; } };

__device__ __forceinline__ void load_wcmp(const Prm& P, Ctx& C, LAS float* wl) { for (int i = C.tid; i < 32 * 256 / 4; i += NTHR) ((LAS f32x4*)wl)[i] = ((const f32x4*)P.w_cmp)[i]; }

__device__ __forceinline__ void phase_prologue(const Prm& P, Ctx& C) {
    unsigned char* ws = P.ws;
    const int gw = C.bid * NWAVES + C.wave, NGW = C.G * NWAVES;
    LAS float* wl = (LAS float*)(C.lds + 73728);
    load_wcmp(P, C, wl);
    __syncthreads();
    bf16_t* KCS = (bf16_t*)(ws + WS_KCS);
    for (int tk = gw; tk < DB * NPAGES; tk += NGW) {
        const int b = tk >> 7, p = tk & 127;
        RowsPaged rp{P.cache_c, P.page_table + b * NPAGES};
        compress_task(rp, PAST, p, wl, KCS + (size_t)b * 1024 * 256, 1023, C.lane);
        if (p == 127) *(u32x2*)(KCS + ((size_t)b * 1024 + 1023) * 256 + 4 * C.lane) = (u32x2){0u, 0u};
    }
    LAS float* scr = (LAS float*)(C.lds + C.wave * 8704);
    for (int it = gw; it < 3968; it += NGW) {
        int r = it;
        if (r < 1792) { const int blk = r >> 4, kb = r & 15; p0_transpose_item(P.w_in_even, E_IN, (bf16_t*)(ws + WS_W1T), 1024, 64 * kb, w1_src_col(blk), 32 * blk, scr, C.lane); continue; } r -= 1792;
        if (r < 512) { const int blk = r >> 4, kb = r & 15; p0_transpose_item(P.w_out_even, 1024, (bf16_t*)(ws + WS_W2T), 1024, 64 * kb, 32 * blk, 32 * blk, scr, C.lane); continue; } r -= 512;
        if (r < 1024) { const int blk = r >> 4, kb = r & 15; p0_transpose_item(P.w_in_odd, 2048, (bf16_t*)(ws + WS_W3T), 1024, 64 * kb, 32 * blk, 32 * blk, scr, C.lane); continue; } r -= 1024;
        if (r < 128) { const int g = r >> 5, rr = r & 31, blk = rr >> 2, kb = rr & 3; p0_transpose_item(P.w_grp + g * 65536, 256, (bf16_t*)(ws + WS_W4T) + g * 65536, 256, 64 * kb, 32 * blk, 32 * blk, scr, C.lane); continue; } r -= 128;
        { const int blk = r >> 4, kb = r & 15; p0_transpose_item(P.w_out_odd, 1024, (bf16_t*)(ws + WS_W5T), 1024, 64 * kb, 32 * blk, 32 * blk, scr, C.lane); }
    }
    bf16_t* XA = (bf16_t*)(ws + WS_XA);
    for (int m = gw; m < MA; m += NGW) {
        const float* src = m < MP ? P.x_prompt + (size_t)m * DM : (m < MR ? P.x_sample + (size_t)(m - MP) * DM : nullptr);
#pragma unroll
        for (int j = 0; j < 4; ++j) { f32x4 v = src ? *(const f32x4*)(src + 4 * C.lane + 256 * j) : (f32x4){0.f, 0.f, 0.f, 0.f};
            u32x2 o; o.x = pk2(v[0], v[1]); o.y = pk2(v[2], v[3]); *(u32x2*)(XA + (size_t)m * DM + 4 * C.lane + 256 * j) = o; }
    }
    const int gt = C.bid * NTHR + C.tid, NGT = C.G * NTHR;
    for (int i = gt; i < DB * 508 * 64; i += NGT) { const int b = i / (508 * 64), r = i % (508 * 64); ((f32x4*)(P.out + O_WINS + (size_t)b * 512 * 256))[r] = ((const f32x4*)(P.state_win + ((size_t)b * 512 + 4) * 256))[r]; }
    for (int i = gt; i < DB * 26 * 128; i += NGT) { const int b = i / (26 * 128), r = i % (26 * 128); ((f32x4*)(P.out + O_CONVS + (size_t)b * 30 * 512))[r] = ((const f32x4*)(P.state_conv + ((size_t)b * 30 + 4) * 512))[r]; }
    for (int i = gt; i < DB * 11 * 256; i += NGT) { const int b = i / (11 * 256), r = i % (11 * 256); ((f32x4*)(P.out + O_POOLS + (size_t)b * 15 * 1024))[r] = ((const f32x4*)(P.state_pool + ((size_t)b * 15 + 4) * 1024))[r]; }
    for (int i = gt; i < (MA - MR) * 1024 / 8; i += NGT) ((u32x4*)(ws + WS_H2 + (size_t)MR * 1024 * 2))[i] = (u32x4){0u, 0u, 0u, 0u};
}

template <int NT, bool SMP>
__device__ __forceinline__ void conv_body(const Prm& P, Ctx& C, int b, int t0) {
    const int c = C.tid;
    const bf16_t* U = (const bf16_t*)(P.ws + WS_U);
    const int row0 = SMP ? MP + 4 * b : b * SEQ + t0;
    float uu[30 + NT];
#pragma unroll
    for (int i = 0; i < 30 + NT; ++i) {
        if (SMP) uu[i] = i < 30 ? P.state_conv[((size_t)b * 30 + i) * 512 + c] : bf2f(U[(size_t)(row0 + i - 30) * 512 + c]);
        else { const int ti = t0 - 30 + i; uu[i] = ti >= 0 ? bf2f(U[(size_t)(row0 + i - 30) * 512 + c]) : 0.f; }
    }
    float w[31];
#pragma unroll
    for (int k = 0; k < 31; ++k) w[k] = P.conv_w[k * 512 + c];
    const float bias = P.conv_b[c];
    LAS float* y = (LAS float*)C.lds;
#pragma unroll
    for (int i = 0; i < NT; ++i) { float a = bias;
#pragma unroll
        for (int k = 0; k < 31; ++k) a += w[k] * uu[i + k];
        y[i * 512 + c] = a; }
    __syncthreads();
    const bf16_t* AG = (const bf16_t*)(P.ws + WS_AG); bf16_t* H2 = (bf16_t*)(P.ws + WS_H2);
    for (int i = C.wave; i < NT; i += NWAVES) {
        float v[8], s = 0.f;
#pragma unroll
        for (int j = 0; j < 8; ++j) { v[j] = y[i * 512 + C.lane + 64 * j]; s += v[j]; }
        const float mean = wave_sum(s) * (1.f / 512.f); float q = 0.f;
#pragma unroll
        for (int j = 0; j < 8; ++j) { v[j] -= mean; q += v[j] * v[j]; }
        const float rstd = 1.f / sqrtf(wave_sum(q) * (1.f / 512.f) + LN_EPS);
        const size_t row = (size_t)(row0 + i);
#pragma unroll
        for (int j = 0; j < 8; ++j) { const int cc = C.lane + 64 * j; float z = v[j] * rstd * P.conv_ln_g[cc] + P.conv_ln_b[cc]; z = siluf_(z) * bf2f(AG[row * 512 + cc]); H2[row * 1024 + cc] = (bf16_t)f2bf(z); }
    }
    __syncthreads();
}

template <int LAYER>
__device__ __forceinline__ void phase_ln(const Prm& P, Ctx& C) {
    const int gw = C.bid * NWAVES + C.wave, NGW = C.G * NWAVES;
    const float* dp = (const float*)(P.ws + (LAYER == 0 ? WS_DP : WS_DP2));
    const float* gam = P.ln_g + LAYER * DM; const float* bet = P.ln_b + LAYER * DM;
    for (int m = gw; m < MR; m += NGW) {
        const float* xin = LAYER == 0 ? (m < MP ? P.x_prompt + (size_t)m * DM : P.x_sample + (size_t)(m - MP) * DM) : (const float*)(P.ws + WS_X1) + (size_t)m * DM;
        float* of = LAYER == 0 ? (float*)(P.ws + WS_X1) + (size_t)m * DM : (m < MP ? P.out + O_Y + (size_t)m * DM : P.out + O_YS + (size_t)(m - MP) * DM);
        f32x4 v[4]; float s = 0.f;
#pragma unroll
        for (int j = 0; j < 4; ++j) { const f32x4 a = *(const f32x4*)(xin + 4 * C.lane + 256 * j), d = *(const f32x4*)(dp + (size_t)m * DM + 4 * C.lane + 256 * j); v[j] = a * ALPHA + d; s += (v[j][0] + v[j][1]) + (v[j][2] + v[j][3]); }
        const float mean = wave_sum(s) * (1.f / DM); float q = 0.f;
#pragma unroll
        for (int j = 0; j < 4; ++j) { v[j] = v[j] - mean; q += (v[j][0] * v[j][0] + v[j][1] * v[j][1]) + (v[j][2] * v[j][2] + v[j][3] * v[j][3]); }
        const float rstd = 1.f / sqrtf(wave_sum(q) * (1.f / DM) + LN_EPS);
#pragma unroll
        for (int j = 0; j < 4; ++j) { const f32x4 gg = *(const f32x4*)(gam + 4 * C.lane + 256 * j), bb = *(const f32x4*)(bet + 4 * C.lane + 256 * j); const f32x4 o = v[j] * rstd * gg + bb;
            *(f32x4*)(of + 4 * C.lane + 256 * j) = o;
            if (LAYER == 0) { u32x2 w; w.x = pk2(o[0], o[1]); w.y = pk2(o[2], o[3]); *(u32x2*)((bf16_t*)(P.ws + WS_X1A) + (size_t)m * DM + 4 * C.lane + 256 * j) = w; } }
    }
}

__device__ __forceinline__ void acc8(float (&s)[8], const u32x4 x, float sg) {
    s[0] += sg * bflo(x.x); s[1] += sg * bfhi(x.x); s[2] += sg * bflo(x.y); s[3] += sg * bfhi(x.y); s[4] += sg * bflo(x.z); s[5] += sg * bfhi(x.z); s[6] += sg * bflo(x.w); s[7] += sg * bfhi(x.w);
}
__device__ __forceinline__ void phase_pool(const Prm& P, Ctx& C) {
    const bf16_t* V = (const bf16_t*)(P.ws + WS_V); bf16_t* D = (bf16_t*)(P.ws + WS_DM);
    const int gt = C.bid * NTHR + C.tid, NGT = C.G * NTHR;
    constexpr int RUN = 32;
    for (int i = gt; i < (MP / RUN) * 128; i += NGT) {
        const int c0 = (i & 127) * 8, row0 = (i >> 7) * RUN, w = 2 << (c0 >> 8), t0 = row0 & (SEQ - 1);
        const bf16_t* vp = V + (size_t)row0 * 1024 + c0;
        float s[8];
#pragma unroll
        for (int e = 0; e < 8; ++e) s[e] = 0.f;
        for (int k = 1; k < w; ++k) if (t0 - k >= 0) acc8(s, *(const u32x4*)(vp - (size_t)k * 1024), 1.f);
#pragma unroll 4
        for (int j = 0; j < RUN; ++j) {
            const int t = t0 + j;
            const u32x4 x = *(const u32x4*)(vp + (size_t)j * 1024);
            acc8(s, x, 1.f);
            const float inv = 1.f / (float)(t + 1 < w ? t + 1 : w);
            u32x4 o; o.x = pk2(s[0] * inv - bflo(x.x), s[1] * inv - bfhi(x.x)); o.y = pk2(s[2] * inv - bflo(x.y), s[3] * inv - bfhi(x.y));
            o.z = pk2(s[4] * inv - bflo(x.z), s[5] * inv - bfhi(x.z)); o.w = pk2(s[6] * inv - bflo(x.w), s[7] * inv - bfhi(x.w));
            *(u32x4*)(D + (size_t)(row0 + j) * 1024 + c0) = o;
            if (t - w + 1 >= 0) acc8(s, *(const u32x4*)(vp + (size_t)(j - w + 1) * 1024), -1.f);
        }
    }
    for (int i = gt; i < MS * 128; i += NGT) {
        const int row = MP + (i >> 7), c0 = (i & 127) * 8, w = 2 << (c0 >> 8);
        const int b = (row - MP) >> 2, ts = (row - MP) & 3;
        float s[8];
#pragma unroll
        for (int e = 0; e < 8; ++e) s[e] = 0.f;
        for (int k = 0; k < w; ++k) { const int e = 15 + ts - k;
            if (e >= 15) acc8(s, *(const u32x4*)(V + (size_t)(MP + 4 * b + e - 15) * 1024 + c0), 1.f);
            else { const float* sp = P.state_pool + ((size_t)b * 15 + e) * 1024 + c0; const f32x4 a = *(const f32x4*)sp, d = *(const f32x4*)(sp + 4);
                s[0] += a[0]; s[1] += a[1]; s[2] += a[2]; s[3] += a[3]; s[4] += d[0]; s[5] += d[1]; s[6] += d[2]; s[7] += d[3]; } }
        const u32x4 x = *(const u32x4*)(V + (size_t)row * 1024 + c0); const float inv = 1.f / (float)w;
        u32x4 o; o.x = pk2(s[0] * inv - bflo(x.x), s[1] * inv - bfhi(x.x)); o.y = pk2(s[2] * inv - bflo(x.y), s[3] * inv - bfhi(x.y));
        o.z = pk2(s[4] * inv - bflo(x.z), s[5] * inv - bfhi(x.z)); o.w = pk2(s[6] * inv - bflo(x.w), s[7] * inv - bfhi(x.w));
        *(u32x4*)(D + (size_t)row * 1024 + c0) = o;
    }
}

#define MFMA32(a, b, c) __builtin_amdgcn_mfma_f32_32x32x16_bf16((a), (b), (c), 0, 0, 0)
__device__ __forceinline__ bf16x8 pack8(const f32x16& p, int base) {
    u32x4 w; w.x = pk2(p[base + 0], p[base + 1]); w.y = pk2(p[base + 2], p[base + 3]); w.z = pk2(p[base + 4], p[base + 5]); w.w = pk2(p[base + 6], p[base + 7]);
    return __builtin_bit_cast(bf16x8, w);
}

__device__ __forceinline__ int dpp_x1(int x) { return __builtin_amdgcn_update_dpp(0, x, 0xB1, 0xF, 0xF, true); }
__device__ __forceinline__ int dpp_x2(int x) { return __builtin_amdgcn_update_dpp(0, x, 0x4E, 0xF, 0xF, true); }
__device__ __forceinline__ float quad_sum(float v) { v += __int_as_float(dpp_x1(__float_as_int(v))); v += __int_as_float(dpp_x2(__float_as_int(v))); return v; }
__device__ __forceinline__ int quad_isum(int v) { v += dpp_x1(v); v += dpp_x2(v); return v; }
__device__ __forceinline__ int half_isum(int v) { auto rr = __builtin_amdgcn_permlane32_swap((unsigned)v, (unsigned)v, false, false); return (int)(rr[0] + rr[1]); }
__device__ __forceinline__ unsigned half_or(unsigned v) { auto rr = __builtin_amdgcn_permlane32_swap(v, v, false, false); return rr[0] | rr[1]; }

template <int NBL>
__device__ __forceinline__ unsigned topk_select(const LAS float* sc  , int sub, int cur) {
    unsigned v[NBL]; unsigned candm = 0u, forced = 0u;
#pragma unroll
    for (int e = 0; e < NBL; ++e) { const int j = sub * NBL + e; const bool cand = (j >= 1) && (j <= cur - 2);
        v[e] = cand ? __float_as_uint(sc[j]) : 0u; if (cand) candm |= 1u << e;
        if (j == 0 || j == cur || (j == cur - 1 && cur >= 1)) forced |= 1u << e; }
    const int nf = cur == 0 ? 1 : (cur == 1 ? 2 : 3), kk = 16 - nf, ncand = cur - 2 > 0 ? cur - 2 : 0;
    unsigned prefix = 0u;
#pragma unroll 1
    for (int bit = 30; bit >= 0; --bit) {
        const unsigned trial = prefix | (1u << bit); int cnt = 0;
#pragma unroll
        for (int e = 0; e < NBL; ++e) cnt += (v[e] >= trial) ? 1 : 0;
        cnt += __shfl_xor(cnt, 1); cnt += __shfl_xor(cnt, 2); cnt += __shfl_xor(cnt, 4);
        if (cnt >= kk) prefix = trial;
    }
    unsigned gt = 0u, eq = 0u;
#pragma unroll
    for (int e = 0; e < NBL; ++e) { if ((candm >> e) & 1u) { if (v[e] > prefix) gt |= 1u << e; else if (v[e] == prefix) eq |= 1u << e; } }
    int ngt = __popc(gt); ngt += __shfl_xor(ngt, 1); ngt += __shfl_xor(ngt, 2); ngt += __shfl_xor(ngt, 4);
    const int eqc = __popc(eq); int inc = eqc;
    { int t1 = __shfl_up(inc, 1, 8); if (sub >= 1) inc += t1; t1 = __shfl_up(inc, 2, 8); if (sub >= 2) inc += t1; t1 = __shfl_up(inc, 4, 8); if (sub >= 4) inc += t1; }
    int take = (kk - ngt) - (inc - eqc); take = take < 0 ? 0 : (take > eqc ? eqc : take);
    unsigned seleq = 0u, tmp = eq;
    for (int i = 0; i < take; ++i) { const unsigned low = tmp & (0u - tmp); seleq |= low; tmp ^= low; }
    const unsigned sel = (ncand <= kk) ? candm : (gt | seleq);
    return sel | forced;
}

constexpr int CK_VS = 1032, CK_K = 0, CK_V = 65536, CK_END = CK_V + 64 * CK_VS;
static_assert(CK_END <= MISC_OFF, "cmp LDS");
__device__ __forceinline__ void cmp_fill_lds(const Prm& P, Ctx& C, int b, int kvh) {
    const bf16_t* src = (const bf16_t*)(P.ws + WS_KC) + (size_t)b * 512 * 256 + kvh * 64;
#pragma unroll
    for (int it = 0; it < 8; ++it) {
        const int idx = it * NTHR + C.tid, k = idx >> 3, c = idx & 7;
        *(LAS u32x4*)(C.lds + CK_K + c * 8192 + k * 16) = *(const u32x4*)(src + (size_t)k * 256 + 8 * c);
    }
#pragma unroll
    for (int it = 0; it < 8; ++it) {
        const int idx = it * NTHR + C.tid, k = idx >> 3, c = idx & 7;
        const u32x4 v = *(const u32x4*)(src + 128 + (size_t)k * 256 + 8 * c);
        LAS bf16_t* d = (LAS bf16_t*)(C.lds + CK_V + (8 * c) * CK_VS) + k;
        const unsigned w[4] = {v.x, v.y, v.z, v.w};
#pragma unroll
        for (int e = 0; e < 4; ++e) { d[(2 * e) * (CK_VS / 2)] = (bf16_t)(w[e] & 0xffffu); d[(2 * e + 1) * (CK_VS / 2)] = (bf16_t)(w[e] >> 16); }
    }
}
__device__ __forceinline__ void cmp_task_lds(const Prm& P, Ctx& C, int b, int kvh, int tg) {
    int lane; asm volatile("v_mbcnt_lo_u32_b32 %0, -1, 0\n\tv_mbcnt_hi_u32_b32 %0, -1, %0" : "=v"(lane));
    const int q = lane & 31, hi = lane >> 5, slot = q >> 2, g = q & 3;
    const int tok = 8 * tg + slot, head = 4 * kvh + g;
    const size_t row = (size_t)b * SEQ + tok;
    const int nvq = tok >= 31 ? ((tok - 31) >> 4) + 1 : 0;
    const int tlast = 8 * tg + 7, nvmax = tlast >= 31 ? ((tlast - 31) >> 4) + 1 : 0, ntile = (nvmax + 31) >> 5;
    const bf16_t* Qp = (const bf16_t*)(P.ws + WS_Q) + row * 512 + head * 64 + 8 * hi;
    bf16x8 qf[4];
#pragma unroll
    for (int s = 0; s < 4; ++s) qf[s] = *(const bf16x8*)(Qp + 16 * s);
    const LAS unsigned char* kb = C.lds + CK_K + hi * 8192 + q * 16;
    const LAS unsigned char* vb = C.lds + CK_V + q * CK_VS + 8 * hi;
    float m = NEGB, l = 0.f;
    for (int tile = 0; tile < ntile; ++tile) {
        f32x16 S = {};
#pragma unroll
        for (int s = 0; s < 4; ++s) S = MFMA32(*(const LAS bf16x8*)(kb + s * 16384 + tile * 512), qf[s], S);
        float tmax = NEGB;
#pragma unroll
        for (int r = 0; r < 16; ++r) { const bool valid = (32 * tile + crow(r, hi)) < nvq; S[r] = valid ? S[r] : NEGB; tmax = fmaxf(tmax, S[r]); }
        const float mn = fmaxf(m, tmax); float ps = 0.f;
#pragma unroll
        for (int r = 0; r < 16; ++r) ps += (S[r] > -1e29f) ? ex2(S[r] - mn) : 0.f;
        l = l * ex2(m - mn) + ps; m = mn;
    }
    { const float mo = __shfl_xor(m, 32), lo = __shfl_xor(l, 32); const float M = fmaxf(m, mo); l = l * ex2(m - M) + lo * ex2(mo - M); m = M; }
    const float invl = l > 0.f ? 1.f / l : 0.f;
    f32x16 o[2]; o[0] = f32x16{}; o[1] = f32x16{};
    float scr[4][4];
#pragma unroll
    for (int a = 0; a < 4; ++a)
#pragma unroll
        for (int i = 0; i < 4; ++i) scr[a][i] = 0.f;
#pragma unroll 1
    for (int k4 = 0; k4 < 4; ++k4) {
        float cur4[4] = {0.f, 0.f, 0.f, 0.f};
#pragma unroll
        for (int tt = 0; tt < 4; ++tt) {
            const int tile = 4 * k4 + tt;
            if (tile < ntile) {
                f32x16 S = {};
#pragma unroll
                for (int s = 0; s < 4; ++s) S = MFMA32(*(const LAS bf16x8*)(kb + s * 16384 + tile * 512), qf[s], S);
#pragma unroll
                for (int r = 0; r < 16; ++r) { const bool valid = (32 * tile + crow(r, hi)) < nvq; S[r] = valid ? ex2(S[r] - m) * invl : 0.f; }
#pragma unroll
                for (int i = 0; i < 4; ++i) { const float v = quad_sum(S[4 * i] + S[4 * i + 1] + S[4 * i + 2]); if (g == tt) cur4[i] = v; }
                bf16x8 pf[2]; pf[0] = pack8(S, 0); pf[1] = pack8(S, 8);
#pragma unroll
                for (int dblk = 0; dblk < 2; ++dblk)
#pragma unroll
                    for (int ks = 0; ks < 2; ++ks) {
                        const LAS unsigned char* vp = vb + dblk * 32 * CK_VS + (32 * tile + 16 * ks) * 2;
                        const s16x4 lo = *(const LAS s16x4*)vp, hh = *(const LAS s16x4*)(vp + 16);
                        o[dblk] = MFMA32(((bf16x8){lo[0], lo[1], lo[2], lo[3], hh[0], hh[1], hh[2], hh[3]}), pf[ks], o[dblk]);
                    }
            }
        }
#pragma unroll
        for (int i = 0; i < 4; ++i) { scr[0][i] = scr[1][i]; scr[1][i] = scr[2][i]; scr[2][i] = scr[3][i]; scr[3][i] = cur4[i]; }
    }
    {
        const float gate = ((const float*)(P.ws + WS_G))[row * 24 + head * 3 + 0];
        bf16_t* op = (bf16_t*)(P.ws + WS_OC) + row * 512 + head * 64;
#pragma unroll
        for (int dblk = 0; dblk < 2; ++dblk)
#pragma unroll
            for (int i = 0; i < 4; ++i) { u32x2 w; w.x = pk2(o[dblk][4 * i] * gate, o[dblk][4 * i + 1] * gate); w.y = pk2(o[dblk][4 * i + 2] * gate, o[dblk][4 * i + 3] * gate);
                *(u32x2*)(op + 32 * dblk + 8 * i + 4 * hi) = w; }
    }
    {
        const int cur = tok >> 6;
        const int nf = cur == 0 ? 1 : (cur == 1 ? 2 : 3), kk = 16 - nf, ncand = cur - 2 > 0 ? cur - 2 : 0;
        unsigned v[16]; unsigned candm = 0u, forced = 0u;
#pragma unroll
        for (int a = 0; a < 4; ++a)
#pragma unroll
            for (int i = 0; i < 4; ++i) { const int j = 32 * a + 8 * g + 2 * i + hi, e = 4 * a + i; const bool cand = (j >= 1) && (j <= cur - 2);
                v[e] = cand ? __float_as_uint(scr[a][i]) : 0u; if (cand) candm |= 1u << e; if (j == 0 || j == cur || (j == cur - 1 && cur >= 1)) forced |= 1u << e; }
        unsigned prefix = 0u;
#pragma unroll 1
        for (int bit = 30; bit >= 0; --bit) {
            const unsigned trial = prefix | (1u << bit); int cnt = 0;
#pragma unroll
            for (int e = 0; e < 16; ++e) cnt += (v[e] >= trial) ? 1 : 0;
            cnt = half_isum(quad_isum(cnt));
            if (cnt >= kk) prefix = trial;
        }
        unsigned gt = 0u, eq = 0u;
#pragma unroll
        for (int e = 0; e < 16; ++e) { if ((candm >> e) & 1u) { if (v[e] > prefix) gt |= 1u << e; else if (v[e] == prefix) eq |= 1u << e; } }
        const int ngt = half_isum(quad_isum(__popc(gt)));
        const int eqc = __popc(eq); int before = 0; const int myrank = 2 * g + hi;
#pragma unroll
        for (int r = 0; r < 8; ++r) { const int c = __shfl(eqc, (lane & 28) + (r >> 1) + 32 * (r & 1)); if (r < myrank) before += c; }
        int take = (kk - ngt) - before; take = take < 0 ? 0 : (take > eqc ? eqc : take);
        unsigned seleq = 0u, tmp = eq;
        for (int i = 0; i < take; ++i) { const unsigned low = tmp & (0u - tmp); seleq |= low; tmp ^= low; }
        const unsigned sel = ((ncand <= kk) ? candm : (gt | seleq)) | forced;
        u32x4 mk;
#pragma unroll
        for (int a = 0; a < 4; ++a) { unsigned w = 0u;
#pragma unroll
            for (int i = 0; i < 4; ++i) if ((sel >> (4 * a + i)) & 1u) w |= 1u << (8 * g + 2 * i + hi);
            w |= (unsigned)dpp_x1((int)w); w |= (unsigned)dpp_x2((int)w); mk[a] = half_or(w); }
        if (g == 0 && hi == 0) *(u32x4*)((unsigned*)(P.ws + WS_SELM) + (row * 2 + kvh) * 4) = mk;
    }
}
__device__ __forceinline__ void cmp_task_sample(const Prm& P, Ctx& C, int task) {
    const int lane = C.lane, q = lane & 31, hi = lane >> 5, slot = q >> 2, g = q & 3, b = task >> 1, kvh = task & 1;
    LAS float* sc = (LAS float*)C.lds;
    LAS float* oacc = (LAS float*)(C.lds + 8192);
    LAS float* ml = (LAS float*)(C.lds + 16384);
    const int tok = slot < 3 ? slot : 3, head = 4 * kvh + g; const size_t row = (size_t)(MP + 4 * b + tok);
    const bf16_t* Kb = (const bf16_t*)(P.ws + WS_KCS) + (size_t)b * 1024 * 256 + kvh * 64; const bf16_t* Vb = Kb + 128;
    const bf16_t* Qp = (const bf16_t*)(P.ws + WS_Q) + row * 512 + head * 64 + 8 * hi;
    bf16x8 qf[4];
#pragma unroll
    for (int s = 0; s < 4; ++s) qf[s] = *(const bf16x8*)(Qp + 16 * s);
    for (int i = C.tid; i < 4096; i += NTHR) sc[i] = 0.f;
    float m = NEGB, l = 0.f;
#pragma unroll 1
    for (int tt = 0; tt < 4; ++tt) { const int tile = C.wave + 8 * tt; const bf16_t* kp = Kb + (size_t)(32 * tile + q) * 256 + 8 * hi;
        f32x16 S = {};
#pragma unroll
        for (int s = 0; s < 4; ++s) S = MFMA32(*(const bf16x8*)(kp + 16 * s), qf[s], S);
        float tmax = NEGB;
#pragma unroll
        for (int r = 0; r < 16; ++r) { const bool valid = (32 * tile + crow(r, hi)) < 1023; S[r] = valid ? S[r] : NEGB; tmax = fmaxf(tmax, S[r]); }
        const float mn = fmaxf(m, tmax); float ps = 0.f;
#pragma unroll
        for (int r = 0; r < 16; ++r) ps += (S[r] > -1e29f) ? ex2(S[r] - mn) : 0.f;
        l = l * ex2(m - mn) + ps; m = mn; }
    { const float mo = __shfl_xor(m, 32), lo = __shfl_xor(l, 32); const float M = fmaxf(m, mo); l = l * ex2(m - M) + lo * ex2(mo - M); m = M; }
    if (hi == 0) { ml[(C.wave * 32 + q) * 2] = m; ml[(C.wave * 32 + q) * 2 + 1] = l; }
    __syncthreads();
    float M = NEGB;
#pragma unroll
    for (int w = 0; w < 8; ++w) M = fmaxf(M, ml[(w * 32 + q) * 2]);
    float L = 0.f;
#pragma unroll
    for (int w = 0; w < 8; ++w) L += ml[(w * 32 + q) * 2 + 1] * ex2(ml[(w * 32 + q) * 2] - M);
    const float invl = L > 0.f ? 1.f / L : 0.f;
    f32x16 o[2]; o[0] = f32x16{}; o[1] = f32x16{};
#pragma unroll 1
    for (int tt = 0; tt < 4; ++tt) { const int tile = C.wave + 8 * tt; const bf16_t* kp = Kb + (size_t)(32 * tile + q) * 256 + 8 * hi;
        f32x16 S = {};
#pragma unroll
        for (int s = 0; s < 4; ++s) S = MFMA32(*(const bf16x8*)(kp + 16 * s), qf[s], S);
#pragma unroll
        for (int r = 0; r < 16; ++r) { const bool valid = (32 * tile + crow(r, hi)) < 1023; S[r] = valid ? ex2(S[r] - M) * invl : 0.f; }
#pragma unroll
        for (int i = 0; i < 4; ++i) { float v = S[4 * i] + S[4 * i + 1] + S[4 * i + 2]; v += __shfl_xor(v, 1); v += __shfl_xor(v, 2); if (g == 0) sc[slot * 256 + 8 * tile + 2 * i + hi] = v; }
        bf16x8 pf[2]; pf[0] = pack8(S, 0); pf[1] = pack8(S, 8);
        const bf16_t* vrow = Vb + (size_t)(32 * tile + 4 * hi) * 256 + q;
#pragma unroll
        for (int dblk = 0; dblk < 2; ++dblk)
#pragma unroll
            for (int ks = 0; ks < 2; ++ks) { bf16x8 vf;
#pragma unroll
                for (int e = 0; e < 8; ++e) vf[e] = (short)vrow[(16 * ks + 8 * (e >> 2) + (e & 3)) * 256 + 32 * dblk];
                o[dblk] = MFMA32(vf, pf[ks], o[dblk]); } }
#pragma unroll
    for (int dblk = 0; dblk < 2; ++dblk)
#pragma unroll
        for (int r = 0; r < 16; ++r) atomicAdd((float*)(oacc + (dblk * 16 + r) * 64 + lane), o[dblk][r]);
    __syncthreads();
    if (C.wave == 0) {
        if (slot < 4) { const float gate = ((const float*)(P.ws + WS_G))[row * 24 + head * 3 + 0]; bf16_t* op = (bf16_t*)(P.ws + WS_OC) + row * 512 + head * 64;
#pragma unroll
            for (int dblk = 0; dblk < 2; ++dblk)
#pragma unroll
                for (int i = 0; i < 4; ++i) { const LAS float* a = oacc + (dblk * 16 + 4 * i) * 64 + lane; u32x2 w; w.x = pk2(a[0] * gate, a[64] * gate); w.y = pk2(a[128] * gate, a[192] * gate);
                    *(u32x2*)(op + 32 * dblk + 8 * i + 4 * hi) = w; } }
        const int slot2 = lane >> 3, sub = lane & 7;
        const unsigned bits = topk_select<32>(sc + slot2 * 256, sub, 256);
        if (slot2 < 4) ((unsigned*)(P.ws + WS_SELMS))[((size_t)(4 * b + slot2) * 2 + kvh) * 8 + sub] = bits;
    }
    __syncthreads();
}
__device__ __forceinline__ void phase_cmp(const Prm& P, Ctx& C) {
    const int npw = C.G >> 3;
    if ((C.G & 7) == 0) {
        const int pr = C.bid & 7, j = C.bid >> 3, b = pr >> 1, kvh = pr & 1;
        cmp_fill_lds(P, C, b, kvh);
        __syncthreads();
        for (int i = C.wave; i * npw < 1024; i += NWAVES) {
            const int tg = i * npw + ((i & 1) ? npw - 1 - j : j);
            if (tg < 1024) cmp_task_lds(P, C, b, kvh, tg);
        }
    } else {
        for (int pr = 0; pr < 8; ++pr) { __syncthreads(); cmp_fill_lds(P, C, pr >> 1, pr & 1); __syncthreads();
            for (int tg = C.bid * NWAVES + C.wave; tg < 1024; tg += C.G * NWAVES) cmp_task_lds(P, C, pr >> 1, pr & 1, tg); }
    }
}

__device__ __forceinline__ void sample_attn_task(const Prm& P, Ctx& C, int task) {
    const int b = task >> 3, kvh = (task >> 2) & 1, ts = task & 3; const size_t row = (size_t)MP + 4 * b + ts;
    LAS float* qs = (LAS float*)C.lds;
    LAS float* part = (LAS float*)(C.lds + 1024);
    LAS float* res = (LAS float*)(C.lds + 1024 + 8 * 4 * 66 * 4);
    LAS int* blist = (LAS int*)(C.lds + 1024 + 8 * 4 * 66 * 4 + 2048);
    const int lane = C.lane, tid = C.tid;
    __syncthreads();
    if (tid < 256) qs[tid] = bf2f(((const bf16_t*)(P.ws + WS_Q))[row * 512 + (4 * kvh + (tid >> 6)) * 64 + (tid & 63)]);
    if (tid == 0) { const unsigned* mk = (const unsigned*)(P.ws + WS_SELMS) + (row - MP) * 16 + kvh * 8; int n = 0;
        for (int w = 0; w < 8; ++w) { unsigned x = mk[w]; while (x && n < 15) { const int bit = __ffs(x) - 1; blist[n++] = 32 * w + bit; x &= x - 1; } }
        while (n < 15) blist[n++] = 0;
        blist[15] = 256; }
    __syncthreads();
#pragma unroll 1
    for (int br = 0; br < 2; ++br) {
        float m[4], l[4], o[4];
#pragma unroll
        for (int gq = 0; gq < 4; ++gq) { m[gq] = NEGB; l[gq] = 0.f; o[gq] = 0.f; }
        const int nseg = br == 0 ? 16 : 9;
#pragma unroll 1
        for (int si = C.wave; si < nseg; si += NWAVES) {
            const float* base; bool valid; int nk = 64;
            if (br == 0) { const int j = blist[si];
                if (j < 256) { const int phys = P.page_table[b * NPAGES + (j >> 1)]; base = P.cache_s + ((size_t)phys * PAGE + (j & 1) * 64) * 256; valid = true; }
                else { base = P.out + O_KSS + (size_t)(b * 4) * 256; valid = lane <= ts; nk = 4; } }
            else { if (si < 8) { base = P.state_win + ((size_t)b * 512 + 64 * si) * 256; valid = (64 * si + lane) >= 1 + ts; }
                else { base = P.out + O_WINS + ((size_t)b * 512 + 508) * 256; valid = lane <= ts; nk = 4; } }
            float s[4] = {0.f, 0.f, 0.f, 0.f};
            if (lane < nk) { const f32x4* kp = (const f32x4*)(base + (size_t)lane * 256 + kvh * 64);
#pragma unroll 4
                for (int c4 = 0; c4 < 16; ++c4) { const f32x4 kv = kp[c4];
#pragma unroll
                    for (int gq = 0; gq < 4; ++gq) { const f32x4 qv = *(const LAS f32x4*)(qs + gq * 64 + 4 * c4); s[gq] += kv[0] * qv[0] + kv[1] * qv[1] + kv[2] * qv[2] + kv[3] * qv[3]; } } }
            valid = valid && lane < nk;
            float p[4];
#pragma unroll
            for (int gq = 0; gq < 4; ++gq) { const float sv = valid ? s[gq] : NEGB; const float mx = wave_max(sv); const float mn = fmaxf(m[gq], mx), a = ex2(m[gq] - mn);
                p[gq] = valid ? ex2(sv - mn) : 0.f; l[gq] = l[gq] * a + p[gq]; o[gq] *= a; m[gq] = mn; }
            const float* vb = base + 128 + kvh * 64 + lane;
#pragma unroll 4
            for (int k = 0; k < nk; ++k) { const float vv = vb[(size_t)k * 256];
#pragma unroll
                for (int gq = 0; gq < 4; ++gq) o[gq] += __uint_as_float(__builtin_amdgcn_readlane(__float_as_uint(p[gq]), k)) * vv; }
        }
#pragma unroll
        for (int gq = 0; gq < 4; ++gq) { const float lt = wave_sum(l[gq]); LAS float* pp = part + (C.wave * 4 + gq) * 66; if (lane == 0) { pp[0] = m[gq]; pp[1] = lt; } pp[2 + lane] = o[gq]; }
        __syncthreads();
        if (tid < 256) { const int gq = tid >> 6, d = tid & 63; float M = NEGB;
            for (int w = 0; w < 8; ++w) M = fmaxf(M, part[(w * 4 + gq) * 66]);
            float L = 0.f, O = 0.f;
            for (int w = 0; w < 8; ++w) { const LAS float* pp = part + (w * 4 + gq) * 66; const float f = ex2(pp[0] - M); L += pp[1] * f; O += pp[2 + d] * f; }
            res[(br * 4 + gq) * 64 + d] = L > 0.f ? O / L : 0.f; }
        __syncthreads();
    }
    if (tid < 256) { const int gq = tid >> 6, d = tid & 63, head = 4 * kvh + gq; const float* G = (const float*)(P.ws + WS_G) + row * 24 + head * 3;
        float v = bf2f(((const bf16_t*)(P.ws + WS_OC))[row * 512 + head * 64 + d]) + G[1] * res[gq * 64 + d] + G[2] * res[(4 + gq) * 64 + d];
        v *= bf2f(((const bf16_t*)(P.ws + WS_BG))[row * 512 + head * 64 + d]);
        ((bf16_t*)(P.ws + WS_H2))[row * 1024 + 512 + head * 64 + d] = (bf16_t)f2bf(v); }
}

__device__ __forceinline__ void phase_conv(const Prm& P, Ctx& C) {
    LAS float* wl = (LAS float*)(C.lds + 73728);
    load_wcmp(P, C, wl);
    __syncthreads();
    for (int un = C.bid; un < 1024 + DB; un += C.G) {
        if (un < 1024) conv_body<32, false>(P, C, un >> 8, (un & 255) * 32);
        else conv_body<4, true>(P, C, un - 1024, 0);
    }
    const int g0 = C.G >= 64 ? 32 : 0, ng = C.G >= 64 ? 32 : C.G;
    bf16_t* KC = (bf16_t*)(P.ws + WS_KC);
    if (C.bid >= g0 && C.bid < g0 + ng)
        for (int tk = (C.bid - g0) * NWAVES + C.wave; tk < NBATCH * 64; tk += ng * NWAVES) {
            const int b = tk >> 6, p = tk & 63;
            RowsFlat rp{P.out + O_KC + (size_t)b * SEQ * 256};
            compress_task(rp, SEQ, p, wl, KC + (size_t)b * 512 * 256, 511, C.lane);
            if (p == 63) *(u32x2*)(KC + ((size_t)b * 512 + 511) * 256 + 4 * C.lane) = (u32x2){0u, 0u};
        }
    __syncthreads();
    const int s0 = C.G >= 128 ? C.G - 64 : 0, nsw = C.G >= 128 ? 64 : C.G;
    if (C.bid >= s0) for (int task = C.bid - s0; task < 64; task += nsw) cmp_task_sample(P, C, task);
}

namespace at2 {
constexpr int QBLK = 32, QB = 256, KVBLK = 64, KP = 256, QP = 512;
constexpr int NSLOT = 3, SLOTB = 8192;
constexpr int WSB = 768;
constexpr int LDS_K = 0, LDS_V = NSLOT * SLOTB, LDS_WS = 2 * NSLOT * SLOTB, LDS_OST = LDS_WS + 8 * WSB, LDS_OS2 = LDS_OST + 8 * 4096, LDS_END = LDS_OS2 + 8 * 4096;
static_assert(LDS_END <= RING_BYTES, "attention LDS");
typedef LAS const char* lds_cptr;
typedef short v4i16_t __attribute__((ext_vector_type(4)));
typedef float f32x2_t __attribute__((ext_vector_type(2))); typedef __bf16 bf16x2_t __attribute__((ext_vector_type(2)));
#define SBAR() __builtin_amdgcn_sched_barrier(0)
#define WAIT_BAR(N) asm volatile("s_waitcnt vmcnt(" #N ") lgkmcnt(0)\n\ts_barrier":::"memory")
__device__ __forceinline__ void glds16(const void* sbase  , unsigned voff, unsigned lds_dst) { unsigned keep;
  asm volatile("s_mov_b32 %0, m0\n\ts_mov_b32 m0, %3\n\ts_nop 0\n\tglobal_load_lds_dwordx4 %1, %2\n\ts_mov_b32 m0, %0" : "=&s"(keep) : "v"(voff), "s"(sbase), "s"(lds_dst) : "memory"); }
__device__ __forceinline__ float max3f(float a, float b, float c) { float r; asm("v_max3_f32 %0, %1, %2, %3" : "=v"(r) : "v"(a), "v"(b), "v"(c)); return r; }
__device__ __forceinline__ float max2f(float a, float b) { float r; asm("v_max_f32_e32 %0, %1, %2" : "=v"(r) : "v"(a), "v"(b)); return r; }
__device__ __forceinline__ float fadd_s(float a, float b) { float r; asm("v_add_f32_e32 %0, %1, %2" : "=v"(r) : "v"(a), "v"(b)); return r; }
__device__ __forceinline__ float fsub_s(float a, float b) { float r; asm("v_sub_f32_e32 %0, %1, %2" : "=v"(r) : "v"(a), "v"(b)); return r; }
__device__ __forceinline__ unsigned cvtpk_s(float lo, float hi) { f32x2_t v = {lo, hi}; bf16x2_t b = __builtin_convertvector(v, bf16x2_t); return __builtin_bit_cast(unsigned, b); }
__device__ __forceinline__ void cmask(f32x16& p0, f32x16& p1, int jb, int qrel, int hi, float NEG) {
  asm volatile("" : "+v"(qrel));
  const int kb = 64 * jb + 4 * hi;
#pragma unroll
  for (int r = 0; r < 16; ++r) { const int kv = kb + (r & 3) + 8 * (r >> 2); if (kv > qrel) p0[r] = NEG; if (kv + 32 > qrel) p1[r] = NEG; }
}
__device__ __forceinline__ void lmask(f32x16& p0, f32x16& p1, int t, int qrel, int hi, float NEG) {
  asm volatile("" : "+v"(qrel));
  const int kb = 64 * t + 4 * hi;
#pragma unroll
  for (int r = 0; r < 16; ++r) { const int kv = kb + (r & 3) + 8 * (r >> 2); if (kv <= qrel) p0[r] = NEG; if (kv + 32 <= qrel) p1[r] = NEG; }
}
__device__ __forceinline__ void kload8(bf16x8* kf, lds_cptr kp) {
  kf[0] = *(const LAS bf16x8*)(kp);        kf[1] = *(const LAS bf16x8*)(kp + 512);
  kf[2] = *(const LAS bf16x8*)(kp + 2048); kf[3] = *(const LAS bf16x8*)(kp + 2560);
  kf[4] = *(const LAS bf16x8*)(kp + 4096); kf[5] = *(const LAS bf16x8*)(kp + 4608);
  kf[6] = *(const LAS bf16x8*)(kp + 6144); kf[7] = *(const LAS bf16x8*)(kp + 6656);
}
__device__ __forceinline__ void kload2(bf16x8* kf, lds_cptr kp, int j) { kf[2 * j] = *(const LAS bf16x8*)(kp + j * 2048); kf[2 * j + 1] = *(const LAS bf16x8*)(kp + j * 2048 + 512); }
__device__ __forceinline__ s16x4 vtr(lds_cptr p) { return __builtin_bit_cast(s16x4, __builtin_amdgcn_ds_read_tr16_b64_v4i16((LAS v4i16_t*)p)); }
__device__ __forceinline__ float rowmax(const f32x16& p0, const f32x16& p1) {
  float a = max3f(p0[0], p0[1], p1[0]), b = max3f(p0[2], p0[3], p1[1]); a = max3f(a, p1[2], p1[3]);
#pragma unroll
  for (int r = 4; r < 16; r += 4) { a = max3f(a, p0[r], p0[r + 1]); b = max3f(b, p0[r + 2], p0[r + 3]); a = max3f(a, p1[r], p1[r + 1]); b = max3f(b, p1[r + 2], p1[r + 3]); }
  const float m = max2f(a, b);
  auto rr = __builtin_amdgcn_permlane32_swap(__float_as_uint(m), __float_as_uint(m), false, false);
  return max2f(__uint_as_float(rr[0]), __uint_as_float(rr[1]));
}
__device__ __forceinline__ void pv(f32x16* o, int vb, bf16x8 pa0, bf16x8 pa1, bf16x8 pa2, bf16x8 pa3) {
#pragma unroll
  for (int d0 = 0; d0 < 2; ++d0) { s16x4 lo[4], hi[4];
#pragma unroll
    for (int ks = 0; ks < 4; ++ks) {
      asm volatile("ds_read_b64_tr_b16 %0,%1 offset:%c2" : "=&v"(lo[ks]) : "v"(vb), "i"(d0 * 4096 + ks * 1024) : "memory");
      asm volatile("ds_read_b64_tr_b16 %0,%1 offset:%c2" : "=&v"(hi[ks]) : "v"(vb), "i"(d0 * 4096 + ks * 1024 + 512) : "memory"); }
    asm volatile("s_waitcnt lgkmcnt(0)" ::: "memory"); SBAR();
#define PK(k) (bf16x8){lo[k][0], lo[k][1], lo[k][2], lo[k][3], hi[k][0], hi[k][1], hi[k][2], hi[k][3]}
    o[d0] = MFMA32(pa0, PK(0), o[d0]); o[d0] = MFMA32(pa1, PK(1), o[d0]); o[d0] = MFMA32(pa2, PK(2), o[d0]); o[d0] = MFMA32(pa3, PK(3), o[d0]);
#undef PK
  }
}

template <int MODE, int THRL>
__device__ __forceinline__ void attn_unit(const Prm& P, int b, int h, int qb, LAS char* shm, int wid) {
  int lane; asm volatile("v_mbcnt_lo_u32_b32 %0, -1, 0\n\tv_mbcnt_hi_u32_b32 %0, -1, %0" : "=v"(lane));
  const int r32 = lane & 31, hi = lane >> 5;
  const int kvh = h >> 2;
  const long rowbase = (long)b * SEQ; const int q0 = qb * QB;
  const int NT = MODE == 0 ? 4 * qb + 4 : (qb >= 2 ? 12 : 4 * qb + 4);
  const int t_lo = 4 * qb + 4 - NT;
  const bool lowband = (MODE == 1) && (NT == 12);
  const float NEG = MODE == 0 ? -INFINITY : -1024.f;
  const bf16_t* Qw = (const bf16_t*)(P.ws + WS_Q) + (rowbase + q0 + wid * QBLK) * QP + h * 64;
  const bf16_t* Kh = (const bf16_t*)(P.ws + (MODE == 0 ? WS_KS : WS_KW)) + (rowbase + (long)t_lo * KVBLK) * KP + kvh * 64;
  const bf16_t* Vh = Kh + 128;
  const unsigned lds0 = (unsigned)(uintptr_t)shm;
  LAS float* wsf = (LAS float*)(shm + LDS_WS + wid * WSB);
  LAS unsigned* selp = (LAS unsigned*)(shm + LDS_WS + wid * WSB + 256) + r32;
  const unsigned ksoff = (unsigned)(lane * KP + wid * 8) * 2u;
  const unsigned vsoff = (unsigned)((16 * (wid & 3) + (lane >> 2)) * KP + (wid >> 2) * 32 + (lane & 3) * 8) * 2u;
  const unsigned kdst = lds0 + LDS_K + wid * 1024, vdst = lds0 + LDS_V + wid * 1024;
#define DMA_K(t, slot) glds16(Kh + (long)(t) * KVBLK * KP, ksoff, (unsigned)__builtin_amdgcn_readfirstlane(kdst + (slot)))
#define DMA_V(t, slot) glds16(Vh + (long)(t) * KVBLK * KP, vsoff, (unsigned)__builtin_amdgcn_readfirstlane(vdst + (slot)))
  const int vb0 = (int)(lds0 + LDS_V) + ((lane >> 4) & 1) * 32 + (lane & 3) * 8 + (4 * hi + ((lane & 15) >> 2)) * 64;
  bf16x8 kf[8];
  const lds_cptr shm3 = (lds_cptr)shm; const lds_cptr kp0 = shm3 + LDS_K + hi * 1024 + r32 * 16; const lds_cptr vp0 = shm3 + LDS_V + ((lane >> 4) & 1) * 32 + (lane & 3) * 8 + (4 * hi + ((lane & 15) >> 2)) * 64;
  DMA_K(0, 0); DMA_V(0, 0); DMA_K(1, SLOTB);
  bf16x8 qr[4];
#pragma unroll
  for (int d0 = 0; d0 < 4; ++d0) qr[d0] = *(const bf16x8*)(&Qw[(long)r32 * QP + d0 * 16 + hi * 8]);
  if (MODE == 0 && hi == 0) { const u32x4 selm = *(const u32x4*)((const unsigned*)(P.ws + WS_SELM) + ((rowbase + q0 + wid * QBLK + r32) * 2 + kvh) * 4);
    selp[0] = selm.x; selp[32] = selm.y; selp[64] = selm.z; selp[96] = selm.w; }
  float mhat = 0.f, l_reg = 0.f; f32x16 o[2]; o[0] = f32x16{}; o[1] = f32x16{}; f32x16 negm = f32x16{}; asm volatile("" : "+v"(negm));
  const int qrel = wid * QBLK + r32;
#define CMASK(P0, P1, t) do { int jb_ = (t) - (NT - 4); if (jb_ >= 0) cmask(P0, P1, jb_, qrel, hi, NEG); if (lowband && (t) < 4) lmask(P0, P1, (t), qrel, hi, NEG); } while (0)
#define NEGSET(t) do { if (MODE == 0) { const int t_ = (t); const unsigned w_ = selp[(t_ >> 5) * 32]; \
    const float cv_ = ((w_ >> (t_ & 31)) & 1u) ? -mhat : -INFINITY; _Pragma("unroll") for (int r = 0; r < 16; ++r) negm[r] = cv_; asm volatile("" : "+v"(negm)); } } while (0)
  bool resc = false;
#define START(P0, P1) do { const float rm = rowmax(P0, P1); resc = false; \
    { const float dl = rm; mhat = fadd_s(mhat, dl); \
      _Pragma("unroll") for (int r = 0; r < 16; ++r) { P0[r] = fsub_s(P0[r], dl); P1[r] = fsub_s(P1[r], dl); } \
      _Pragma("unroll") for (int r = 0; r < 16; ++r) negm[r] = -mhat; asm volatile("" : "+v"(negm)); } \
    _Pragma("unroll") for (int r = 0; r < 16; ++r) P0[r] = __builtin_amdgcn_exp2f(P0[r]); } while (0)
#define RESC() do { if (resc) { asm volatile("s_waitcnt lgkmcnt(0)" ::: "memory"); \
      _Pragma("unroll") for (int d_ = 0; d_ < 2; ++d_) _Pragma("unroll") for (int r = 0; r < 16; ++r) o[d_][r] *= wsf[crow(r, hi)]; } } while (0)
  f32x16 pA0, pA1, pB0, pB1;
  int sl_prev = 0, sl_cur = 0, sl_next = SLOTB;
#define ROT() do { sl_prev = sl_cur; sl_cur = sl_next; sl_next = (sl_next == (NSLOT - 1) * SLOTB) ? 0 : sl_next + SLOTB; } while (0)
  DMA_K(2, 2 * SLOTB);
  WAIT_BAR(3);
  {
    const lds_cptr kb = shm3 + LDS_K + hi * 1024 + r32 * 16;
#pragma unroll
    for (int d0 = 0; d0 < 4; ++d0) {
      const bf16x8 b0 = *(const LAS bf16x8*)(kb + d0 * 2048), b1 = *(const LAS bf16x8*)(kb + d0 * 2048 + 512);
      if (d0 == 0) { pA0 = MFMA32(b0, qr[0], negm); pA1 = MFMA32(b1, qr[0], negm); }
      else { pA0 = MFMA32(b0, qr[d0], pA0); pA1 = MFMA32(b1, qr[d0], pA1); } }
  }
  asm volatile("s_nop 15\n\ts_nop 7" : "+v"(pA0), "+v"(pA1)); CMASK(pA0, pA1, 0);
  START(pA0, pA1);
#pragma unroll
  for (int r = 0; r < 16; ++r) pA1[r] = __builtin_amdgcn_exp2f(pA1[r]);
  WAIT_BAR(0);
  DMA_K(3, 0); DMA_V(1, SLOTB);
  ROT();
  kload8(kf, kp0 + sl_cur);
  WAIT_BAR(2);
  s16x4 vlo[8], vhi[8]; u32x4 pw0, pw1, pw2, pw3;
#define PKW(P, B) cvtpk_s(P[B], P[B + 1])
#define PAF(k) __builtin_bit_cast(bf16x8, pw##k)
#define VFR(i) (bf16x8){vlo[i][0], vlo[i][1], vlo[i][2], vlo[i][3], vhi[i][0], vhi[i][1], vhi[i][2], vhi[i][3]}
#define PIN(x) asm volatile("" : "+v"(x))
#define MX3(a, b, c) __builtin_fmaxf(__builtin_fmaxf((a), (b)), (c))
#define GAPA(MF, A0, A1, A2, A3, W0, W1, PW) do { MF; sacc += A0; sacc += A1; sacc += A2; sacc += A3; PIN(sacc); W0; W1; PIN(PW); SBAR(); } while (0)
#define EX(v) __builtin_amdgcn_exp2f(v)
#define GAPB(MF, X, B) do { MF; X[B] = EX(X[B]); X[B + 1] = EX(X[B + 1]); X[B + 2] = EX(X[B + 2]); X[B + 3] = EX(X[B + 3]); PIN(X); SBAR(); } while (0)
#define VRD(i) do { vlo[i] = vtr(vp_ + (((i) >> 2) * 4096 + ((i) & 3) * 1024)); vhi[i] = vtr(vp_ + (((i) >> 2) * 4096 + ((i) & 3) * 1024 + 512)); } while (0)
#define KRD(G, j) do { if (G) { kload2(kf, kp0 + sl_next, j); SBAR(); } } while (0)
#define STEP(C0, C1, P0, P1, t, GK, GV, GL) do { SBAR(); \
    NEGSET(t); \
    const lds_cptr vp_ = vp0 + sl_prev; \
    VRD(0); SBAR(); float sacc = (P0[0] + P0[1]); \
    GAPA(C0 = MFMA32(kf[0], qr[0], negm), P0[2], P0[3], P0[4], P0[5],     pw0[0] = PKW(P0, 0), pw0[1] = PKW(P0, 2), pw0); \
    VRD(4); SBAR(); GAPA(C1 = MFMA32(kf[1], qr[0], negm), P0[6], P0[7], P0[8], P0[9],     pw0[2] = PKW(P0, 4), pw0[3] = PKW(P0, 6), pw0); \
    VRD(1); SBAR(); GAPA(C0 = MFMA32(kf[2], qr[1], C0),   P0[10], P0[11], P0[12], P0[13], pw1[0] = PKW(P0, 8), pw1[1] = PKW(P0, 10), pw1); \
    VRD(5); SBAR(); GAPA(C1 = MFMA32(kf[3], qr[1], C1),   P0[14], P0[15], P1[0], P1[1],   pw1[2] = PKW(P0, 12), pw1[3] = PKW(P0, 14), pw1); \
    VRD(2); SBAR(); GAPA(C0 = MFMA32(kf[4], qr[2], C0),   P1[2], P1[3], P1[4], P1[5],     pw2[0] = PKW(P1, 0), pw2[1] = PKW(P1, 2), pw2); \
    VRD(6); SBAR(); GAPA(C1 = MFMA32(kf[5], qr[2], C1),   P1[6], P1[7], P1[8], P1[9],     pw2[2] = PKW(P1, 4), pw2[3] = PKW(P1, 6), pw2); \
    VRD(3); SBAR(); GAPA(C0 = MFMA32(kf[6], qr[3], C0),   P1[10], P1[11], P1[12], P1[13], pw3[0] = PKW(P1, 8), pw3[1] = PKW(P1, 10), pw3); \
    VRD(7); SBAR(); GAPA(C1 = MFMA32(kf[7], qr[3], C1),   P1[14], P1[15], 0.f, 0.f,       pw3[2] = PKW(P1, 12), pw3[3] = PKW(P1, 14), pw3); \
    l_reg += sacc; \
    if (GK) { DMA_K((t) + 3, sl_cur); } if (GV) { DMA_V((t) + 1, sl_next); } \
    CMASK(C0, C1, t); \
    { float a = MX3(C0[0], C0[1], C1[0]), b_ = MX3(C0[2], C0[3], C1[1]); a = MX3(a, C1[2], C1[3]); \
      _Pragma("unroll") for (int r = 4; r < 16; r += 4) { a = MX3(a, C0[r], C0[r + 1]); b_ = MX3(b_, C0[r + 2], C0[r + 3]); a = MX3(a, C1[r], C1[r + 1]); b_ = MX3(b_, C1[r + 2], C1[r + 3]); } \
      float rm = __builtin_fmaxf(a, b_); { auto rr = __builtin_amdgcn_permlane32_swap(__float_as_uint(rm), __float_as_uint(rm), false, false); rm = __builtin_fmaxf(__uint_as_float(rr[0]), __uint_as_float(rr[1])); } \
      resc = false; \
      if (__builtin_expect(__any(rm > (float)THRL), 0)) { const float dl = __builtin_fmaxf(rm, 0.f); mhat += dl; \
        _Pragma("unroll") for (int r = 0; r < 16; ++r) { C0[r] -= dl; C1[r] -= dl; } \
        _Pragma("unroll") for (int r = 0; r < 16; ++r) negm[r] = -mhat; asm volatile("" : "+v"(negm)); \
        const float f = __builtin_amdgcn_exp2f(-dl); l_reg *= f; if (hi == 0) wsf[r32] = f; resc = true; } } \
    SBAR(); \
    GAPB(o[0] = MFMA32(PAF(0), VFR(0), o[0]), C0, 0); \
    GAPB(o[1] = MFMA32(PAF(0), VFR(4), o[1]), C0, 4); \
    KRD(GL, 0); GAPB(o[0] = MFMA32(PAF(1), VFR(1), o[0]), C0, 8); \
    KRD(GL, 1); GAPB(o[1] = MFMA32(PAF(1), VFR(5), o[1]), C0, 12); \
    KRD(GL, 2); GAPB(o[0] = MFMA32(PAF(2), VFR(2), o[0]), C1, 0); \
    KRD(GL, 3); GAPB(o[1] = MFMA32(PAF(2), VFR(6), o[1]), C1, 4); \
    GAPB(o[0] = MFMA32(PAF(3), VFR(3), o[0]), C1, 8); \
    GAPB(o[1] = MFMA32(PAF(3), VFR(7), o[1]), C1, 12); \
    } while (0)
  int t = 1;
#undef CMASK
#define CMASK(P0, P1, t) do { if (lowband && (t) < 4) lmask(P0, P1, (t), qrel, hi, NEG); } while (0)
  for (; t + 5 < NT; t += 2) {
    STEP(pB0, pB1, pA0, pA1, t, true, true, true);     WAIT_BAR(2); RESC(); ROT();
    STEP(pA0, pA1, pB0, pB1, t + 1, true, true, true); WAIT_BAR(2); RESC(); ROT();
  }
#undef CMASK
#define CMASK(P0, P1, t) do { int jb_ = (t) - (NT - 4); if (jb_ >= 0) cmask(P0, P1, jb_, qrel, hi, NEG); if (lowband && (t) < 4) lmask(P0, P1, (t), qrel, hi, NEG); } while (0)
#define ENDW(tt) do { if ((tt) + 3 < NT) { WAIT_BAR(2); } else if ((tt) + 2 < NT) { WAIT_BAR(1); } else { WAIT_BAR(0); } } while (0)
  for (; t + 1 < NT; t += 2) {
    STEP(pB0, pB1, pA0, pA1, t, (t + 3 < NT), (t + 1 < NT), (t + 1 < NT));         ENDW(t);     RESC(); ROT();
    STEP(pA0, pA1, pB0, pB1, t + 1, (t + 4 < NT), (t + 2 < NT), (t + 2 < NT));     ENDW(t + 1); RESC(); ROT();
  }
  STEP(pB0, pB1, pA0, pA1, NT - 1, false, false, false); RESC();
  { float sacc = pB0[0] + pB0[1];
#pragma unroll
    for (int r = 2; r < 16; ++r) sacc += pB0[r];
#pragma unroll
    for (int r = 0; r < 16; ++r) sacc += pB1[r];
    l_reg += sacc;
    pw0 = (u32x4){PKW(pB0, 0), PKW(pB0, 2), PKW(pB0, 4), PKW(pB0, 6)}; pw1 = (u32x4){PKW(pB0, 8), PKW(pB0, 10), PKW(pB0, 12), PKW(pB0, 14)};
    pw2 = (u32x4){PKW(pB1, 0), PKW(pB1, 2), PKW(pB1, 4), PKW(pB1, 6)}; pw3 = (u32x4){PKW(pB1, 8), PKW(pB1, 10), PKW(pB1, 12), PKW(pB1, 14)};
    SBAR(); pv(o, vb0 + sl_cur, PAF(0), PAF(1), PAF(2), PAF(3)); }
#undef PKW
#undef PAF
#undef VFR
#undef PIN
#undef MX3
#undef GAPA
#undef GAPB
#undef EX
#undef VRD
#undef KRD
#undef STEP
#undef ENDW
  { auto rr = __builtin_amdgcn_permlane32_swap(__float_as_uint(l_reg), __float_as_uint(l_reg), false, false); l_reg = __uint_as_float(rr[0]) + __uint_as_float(rr[1]); }
  const long row0 = rowbase + q0 + wid * QBLK;
  if (hi == 0) { const float gte = ((const float*)(P.ws + WS_G))[(row0 + r32) * 24 + h * 3 + (MODE == 0 ? 1 : 2)]; wsf[32 + r32] = l_reg > 0.f ? gte * __builtin_amdgcn_rcpf(l_reg) : 0.f; }
  asm volatile("s_waitcnt lgkmcnt(0)" ::: "memory");
  float rli[16];
#pragma unroll
  for (int r = 0; r < 16; ++r) rli[r] = wsf[32 + crow(r, hi)];
  { LAS bf16_t* stg = (LAS bf16_t*)(shm + (MODE == 0 ? LDS_OS2 : LDS_OST)) + wid * 2048;
#pragma unroll
    for (int r = 0; r < 16; ++r) { const int orow = crow(r, hi);
#pragma unroll
      for (int d0 = 0; d0 < 2; ++d0) stg[orow * 64 + d0 * 32 + r32] = (bf16_t)f2bf(o[d0][r] * rli[r]); }
    asm volatile("s_waitcnt lgkmcnt(0)" ::: "memory");
    if (MODE == 1) {
      const LAS bf16_t* stg2 = (const LAS bf16_t*)(shm + LDS_OS2) + wid * 2048;
      const bf16_t* ocp = (const bf16_t*)(P.ws + WS_OC) + row0 * 512 + h * 64;
      const bf16_t* bgp = (const bf16_t*)(P.ws + WS_BG) + row0 * 512 + h * 64;
      bf16_t* hp = (bf16_t*)(P.ws + WS_H2) + row0 * 1024 + 512 + h * 64;
      int lane_e = lane; asm volatile("" : "+v"(lane_e));
#pragma unroll
      for (int i = 0; i < 4; ++i) { const int row = i * 8 + (lane_e >> 3), ch = lane_e & 7;
        const u32x4 a = *(const LAS u32x4*)(stg + row * 64 + ch * 8), s2 = *(const LAS u32x4*)(stg2 + row * 64 + ch * 8);
        const u32x4 oc = *(const u32x4*)(ocp + (long)row * 512 + ch * 8), bg = *(const u32x4*)(bgp + (long)row * 512 + ch * 8);
        u32x4 w;
        w.x = pk2((bflo(a.x) + bflo(s2.x) + bflo(oc.x)) * bflo(bg.x), (bfhi(a.x) + bfhi(s2.x) + bfhi(oc.x)) * bfhi(bg.x));
        w.y = pk2((bflo(a.y) + bflo(s2.y) + bflo(oc.y)) * bflo(bg.y), (bfhi(a.y) + bfhi(s2.y) + bfhi(oc.y)) * bfhi(bg.y));
        w.z = pk2((bflo(a.z) + bflo(s2.z) + bflo(oc.z)) * bflo(bg.z), (bfhi(a.z) + bfhi(s2.z) + bfhi(oc.z)) * bfhi(bg.z));
        w.w = pk2((bflo(a.w) + bflo(s2.w) + bflo(oc.w)) * bflo(bg.w), (bfhi(a.w) + bfhi(s2.w) + bfhi(oc.w)) * bfhi(bg.w));
        *(u32x4*)(hp + (long)row * 1024 + ch * 8) = w; }
    }
  }
  asm volatile("s_waitcnt vmcnt(0) lgkmcnt(0)\n\ts_barrier" ::: "memory");
#undef DMA_K
#undef DMA_V
#undef CMASK
#undef NEGSET
#undef START
#undef RESC
#undef ROT
}
#undef SBAR
#undef WAIT_BAR
}

__device__ __forceinline__ void phase_attn(const Prm& P, Ctx& C) {
    for (int task = C.bid; task < 256; task += C.G) sample_attn_task(P, C, task);
    __syncthreads();
    const bool bal = (C.G == 256);
    const int vcu = (C.bid & 7) * 32 + (C.bid >> 3), s = vcu & 7;
#pragma unroll 1
    for (int i = 0;; ++i) {
        int bh, qb;
        if (bal) { if (i >= 4) break; bh = vcu >> 3; qb = (i == 0) ? s : (i == 1) ? 15 - s : (i == 2) ? 16 + s : 31 - s; }
        else { const int u = i * C.G + C.bid; if (u >= 1024) break; bh = u >> 5; qb = u & 31; }
        at2::attn_unit<0, 8>(P, bh >> 3, bh & 7, qb, (LAS char*)C.lds, C.wave);
        at2::attn_unit<1, 8>(P, bh >> 3, bh & 7, qb, (LAS char*)C.lds, C.wave);
    }
}

constexpr int NPHASE = 12;
__global__ void __launch_bounds__(NTHR, 2) fwd(Prm P) {
    extern __shared__ __attribute__((aligned(16))) unsigned char lds_raw[];
    Ctx C; C.lds = (LAS unsigned char*)lds_raw; C.tid = threadIdx.x; C.lane = C.tid & 63; C.wave = __builtin_amdgcn_readfirstlane(C.tid >> 6); C.G = gridDim.x; C.bid = blockIdx.x;
#define FRESH() do { int l_; asm volatile("v_mbcnt_lo_u32_b32 %0, -1, 0\n\tv_mbcnt_hi_u32_b32 %0, -1, %0" : "=v"(l_)); C.lane = l_; C.tid = C.wave * 64 + l_; } while (0)
    volatile LAS unsigned* MISC = (volatile LAS unsigned*)(C.lds + MISC_OFF);
    if (C.tid < 32) MISC[C.tid] = 0u;
    __syncthreads();
    unsigned char* ws = P.ws;
    unsigned* ctl = (unsigned*)(ws + WS_CTL);
    XcdBarrier bar; bar.bar = ctl + CW_BAR; bar.x = 0; bar.st = nullptr;
    const int lo = P.ph_lo, hi = P.ph_hi;
    if (hi - lo > 1) bar = xcd_barrier_post(ctl + CW_BAR, MISC + 8);
#define IN(k) (lo <= (k) && (k) < hi)
#define REP(k) _Pragma("unroll") for (int rep_ = 0; rep_ < 1 + ((REPEAT_MASK >> (k)) & 1); ++rep_)
#define SEAM(k) do { if (IN(k) && IN((k) + 1)) xcd_barrier(bar); } while (0)

    if (IN(0)) REP(0) { FRESH(); phase_prologue(P, C); } SEAM(0);
    if (IN(1)) REP(1) { FRESH();
        pg8::Gemm g{(const bf16_t*)(ws + WS_XA), (const bf16_t*)(ws + WS_W1T), 1024, 1024, 1024, 0};
        pg8::StaticOrder S; S.init(MA, N1, C.G, C.bid);
        Epi1 E{(bf16_t*)(ws + WS_U), (bf16_t*)(ws + WS_AG), (bf16_t*)(ws + WS_Q), (bf16_t*)(ws + WS_KS), (bf16_t*)(ws + WS_KW), (bf16_t*)(ws + WS_BG), (float*)(ws + WS_G), P.out};
        pg8::gemm_phase<Epi1, pg8::StaticOrder>(C.lds, g, S, E, C.tid);
    } SEAM(1);
    if (IN(2)) REP(2) { FRESH(); phase_conv(P, C); } SEAM(2);
    if (IN(3)) REP(3) { FRESH(); phase_cmp(P, C); } SEAM(3);
    if (IN(4)) REP(4) { FRESH(); phase_attn(P, C); } SEAM(4);
    if (IN(5)) REP(5) { FRESH();
        pg8::Gemm g{(const bf16_t*)(ws + WS_H2), (const bf16_t*)(ws + WS_W2T), 1024, 1024, 1024, 0};
        pg8::StaticOrder S; S.init(MA, 1024, C.G, C.bid);
        EpiF32 E{(float*)(ws + WS_DP), 1024};
        pg8::gemm_phase<EpiF32, pg8::StaticOrder>(C.lds, g, S, E, C.tid);
    } SEAM(5);
    if (IN(6)) REP(6) { FRESH(); phase_ln<0>(P, C); } SEAM(6);
    if (IN(7)) REP(7) { FRESH();
        pg8::Gemm g{(const bf16_t*)(ws + WS_X1A), (const bf16_t*)(ws + WS_W3T), 1024, 1024, 1024, 0};
        pg8::StaticOrder S; S.init(MA, 2048, C.G, C.bid);
        Epi3 E{(bf16_t*)(ws + WS_V), (bf16_t*)(ws + WS_GT), P.out};
        pg8::gemm_phase<Epi3, pg8::StaticOrder>(C.lds, g, S, E, C.tid);
    } SEAM(7);
    if (IN(8)) REP(8) { FRESH(); phase_pool(P, C); } SEAM(8);
    if (IN(9)) REP(9) { FRESH();
        pg8::Gemm g{(const bf16_t*)(ws + WS_DM), (const bf16_t*)(ws + WS_W4T), 1024, 256, 256, 256};
        pg8::StaticOrder S; S.init(MA, 1024, C.G, C.bid);
        Epi4 E{(const bf16_t*)(ws + WS_GT), P.pool_scale, (bf16_t*)(ws + WS_MX)};
        pg8::gemm_phase<Epi4, pg8::StaticOrder>(C.lds, g, S, E, C.tid);
    } SEAM(9);
    if (IN(10)) REP(10) { FRESH();
        pg8::Gemm g{(const bf16_t*)(ws + WS_MX), (const bf16_t*)(ws + WS_W5T), 1024, 1024, 1024, 0};
        pg8::StaticOrder S; S.init(MA, 1024, C.G, C.bid);
        EpiF32 E{(float*)(ws + WS_DP2), 1024};
        pg8::gemm_phase<EpiF32, pg8::StaticOrder>(C.lds, g, S, E, C.tid);
    } SEAM(10);
    if (IN(11)) REP(11) { FRESH(); phase_ln<1>(P, C); }
#undef IN
#undef FRESH
#undef REP
#undef SEAM
}

extern "C" void kernel_launch(void* const* d_in, const int* in_sizes, int n_in, void* d_out, int out_size, void* d_ws, size_t ws_size, hipStream_t stream) {
    static int grid = 0;
    if (grid == 0) {
        if (n_in != 21 || (size_t)out_size != O_TOTAL || ws_size < WS_END) { fprintf(stderr, "kernel_launch: unexpected sizes n_in %d out %d ws %zu\n", n_in, out_size, ws_size); grid = -1; return; }
        int dev = 0, cus = 0, per_cu = 0;
        if (hipGetDevice(&dev) != hipSuccess || hipDeviceGetAttribute(&cus, hipDeviceAttributeMultiprocessorCount, dev) != hipSuccess) { grid = -1; return; }
        if (hipFuncSetAttribute((const void*)fwd, hipFuncAttributeMaxDynamicSharedMemorySize, LDS_BYTES) != hipSuccess) { fprintf(stderr, "kernel_launch: hipFuncSetAttribute failed\n"); grid = -1; return; }
        if (hipOccupancyMaxActiveBlocksPerMultiprocessor(&per_cu, (const void*)fwd, NTHR, LDS_BYTES) != hipSuccess || per_cu < 1) fprintf(stderr, "kernel_launch: occupancy query says %d\n", per_cu);
        (void)hipGetLastError();
        grid = cus;
    }
    if (grid < 0) return;
    (void)hipMemsetAsync((char*)d_ws + WS_CTL, 0, CTL_ZERO_BYTES, stream);
    Prm p{};
    p.x_prompt = (const float*)d_in[0]; p.x_sample = (const float*)d_in[1]; p.cache_c = (const float*)d_in[2]; p.cache_s = (const float*)d_in[3];
    p.state_win = (const float*)d_in[4]; p.state_conv = (const float*)d_in[5]; p.state_pool = (const float*)d_in[6]; p.page_table = (const int*)d_in[7];
    p.w_in_even = (const float*)d_in[8]; p.w_cmp = (const float*)d_in[9]; p.conv_w = (const float*)d_in[10]; p.conv_b = (const float*)d_in[11];
    p.conv_ln_g = (const float*)d_in[12]; p.conv_ln_b = (const float*)d_in[13]; p.w_out_even = (const float*)d_in[14]; p.w_in_odd = (const float*)d_in[15];
    p.w_grp = (const float*)d_in[16]; p.pool_scale = (const float*)d_in[17]; p.w_out_odd = (const float*)d_in[18]; p.ln_g = (const float*)d_in[19]; p.ln_b = (const float*)d_in[20];
    p.out = (float*)d_out; p.ws = (unsigned char*)d_ws;
#if N_LAUNCH_MODE == 1
    p.ph_lo = 0; p.ph_hi = NPHASE;
    hipLaunchKernelGGL(fwd, dim3(grid), dim3(NTHR), LDS_BYTES, stream, p);
#else
    for (int ph = 0; ph < NPHASE; ++ph) { p.ph_lo = ph; p.ph_hi = ph + 1; hipLaunchKernelGGL(fwd, dim3(grid), dim3(NTHR), LDS_BYTES, stream, p); }
#endif
}
```
